# Optimizing an MI355X kernel written in HIP

```python
import math
import jax, jax.numpy as jnp
from jax import lax
import numpy as np

D_MODEL = 1024
BATCH = 16
SEQ = 2048
DEPTH = 1

CHUNK = 64
N_MEM = 256
EPS = 1e-6
ROPE_THETA = 10000.0
NEG = -1e30

A_HEADS = 4
A_DK = 64
A_DV = 2 * A_DK
A_QK_W = A_HEADS * 2 * A_DK
A_WIDTH = A_HEADS * A_DV
Q_BLOCK = 128

B_HEADS = 8
B_DH = 64
B_WIDTH = B_HEADS * B_DH
B_LEFT_CHUNKS = 8
B_MAX_REL = 256

X_HEADS = 4
X_DH = D_MODEL // X_HEADS

D_FF = -(-(8 * D_MODEL) // (3 * 256)) * 256

OFF_QA = 0
OFF_KA = OFF_QA + A_QK_W
OFF_VA = OFF_KA + A_QK_W
OFF_QB = OFF_VA + A_WIDTH
OFF_KB = OFF_QB + B_WIDTH
OFF_VB = OFF_KB + B_WIDTH
OFF_GA = OFF_VB + B_WIDTH
OFF_GB = OFF_GA + D_MODEL
IN_COLS = OFF_GB + D_MODEL

kernel_name = "hybrid_diffattn_chunkband_memxattn_swiglu"


def rmsnorm(x, g):
    xf = x.astype(jnp.float32)
    y = xf * lax.rsqrt(jnp.mean(xf * xf, axis=-1, keepdims=True) + EPS)
    return (y * g.astype(jnp.float32)).astype(x.dtype)


def rope_tables(seq, dim):
    inv = 1.0 / (ROPE_THETA ** (jnp.arange(0, dim, 2, dtype=jnp.float32) / dim))
    ang = jnp.arange(seq, dtype=jnp.float32)[:, None] * inv[None, :]
    return jnp.cos(ang), jnp.sin(ang)


def apply_rope(x, cos, sin):
    x1, x2 = jnp.split(x.astype(jnp.float32), 2, axis=-1)
    out = jnp.concatenate([x1 * cos - x2 * sin, x2 * cos + x1 * sin], axis=-1)
    return out.astype(x.dtype)


def diff_attention(q, k, v, lam, subln_g, lam_init):
    b, s = q.shape[0], q.shape[1]
    nqb = s // Q_BLOCK
    scale = A_DK ** -0.5
    k_chunk = jnp.arange(s) // CHUNK
    qb = q.reshape(b, nqb, Q_BLOCK, A_HEADS, 2, A_DK).transpose(1, 0, 2, 3, 4, 5)

    def one_block(args):
        qi, blk = args
        sc = jnp.einsum('bqhcd,bkhcd->bchqk', qi, k).astype(jnp.float32) * scale
        q_chunk = (blk * Q_BLOCK + jnp.arange(Q_BLOCK)) // CHUNK
        mask = k_chunk[None, :] <= q_chunk[:, None]
        sc = jnp.where(mask[None, None, None], sc, NEG)
        p = jax.nn.softmax(sc, axis=-1)
        attn = p[:, 0] - lam * p[:, 1]
        return jnp.einsum('bhqk,bkhd->bqhd', attn.astype(v.dtype), v)

    o = lax.map(one_block, (qb, jnp.arange(nqb)))
    o = o.transpose(1, 0, 2, 3, 4).reshape(b, s, A_HEADS, A_DV)
    o = rmsnorm(o, subln_g) * (1.0 - lam_init)
    return o.reshape(b, s, A_WIDTH)


def chunk_band_attention(q, k, v, rel_bias):
    b, s = q.shape[0], q.shape[1]
    nc = s // CHUNK
    pad = B_LEFT_CHUNKS * CHUNK
    band = pad + CHUNK
    scale = B_DH ** -0.5
    kp = jnp.pad(k, ((0, 0), (pad, 0), (0, 0), (0, 0)))
    vp = jnp.pad(v, ((0, 0), (pad, 0), (0, 0), (0, 0)))
    i = jnp.arange(CHUNK)
    j = jnp.arange(band)
    dist = i[:, None] + pad - j[None, :]
    idx = jnp.clip(dist, -B_MAX_REL, B_MAX_REL) + B_MAX_REL
    bias = rel_bias[:, idx].astype(jnp.float32)
    qc = q.reshape(b, nc, CHUNK, B_HEADS, B_DH).transpose(1, 0, 2, 3, 4)

    def one_chunk(args):
        qi, c = args
        start = c * CHUNK
        kb = lax.dynamic_slice_in_dim(kp, start, band, axis=1)
        vb = lax.dynamic_slice_in_dim(vp, start, band, axis=1)
        sc = jnp.einsum('bqhd,bkhd->bhqk', qi, kb).astype(jnp.float32) * scale + bias[None]
        valid = (start + j) >= pad
        sc = jnp.where(valid[None, None, None, :], sc, NEG)
        p = jax.nn.softmax(sc, axis=-1)
        return jnp.einsum('bhqk,bkhd->bqhd', p.astype(vb.dtype), vb)

    o = lax.map(one_chunk, (qc, jnp.arange(nc)))
    return o.transpose(1, 0, 2, 3, 4).reshape(b, s, B_WIDTH)


def memory_cross_attention(h, m, w_cq, w_ckv, w_co):
    b, s = h.shape[0], h.shape[1]
    nm = m.shape[1]
    q = (h @ w_cq).reshape(b, s, X_HEADS, X_DH)
    k, v = jnp.split(m @ w_ckv, 2, axis=-1)
    k = k.reshape(b, nm, X_HEADS, X_DH)
    v = v.reshape(b, nm, X_HEADS, X_DH)
    sc = jnp.einsum('bshd,bmhd->bhsm', q, k).astype(jnp.float32) * (X_DH ** -0.5)
    p = jax.nn.softmax(sc, axis=-1)
    o = jnp.einsum('bhsm,bmhd->bshd', p.astype(v.dtype), v).reshape(b, s, D_MODEL)
    return o @ w_co


def swiglu(h, w_gate_up, w_down):
    g, u = jnp.split(h @ w_gate_up, 2, axis=-1)
    return (jax.nn.silu(g) * u) @ w_down


def setup_inputs(seed: int = 0) -> dict:
    key = jax.random.key(seed)
    ks = jax.random.split(key, 24)
    nrm = lambda k, shape, sc: jax.random.normal(k, shape, jnp.float32) * sc
    gain = lambda k, shape: 1.0 + 0.05 * jax.random.normal(k, shape, jnp.float32)
    L = DEPTH
    return {
        "x": nrm(ks[0], (BATCH, SEQ, D_MODEL), 1.0),
        "mem": nrm(ks[1], (BATCH, N_MEM, D_MODEL), 1.0),
        "norm_mix_g": gain(ks[2], (L, D_MODEL)),
        "w_in": nrm(ks[3], (L, D_MODEL, IN_COLS), D_MODEL ** -0.5),
        "lam_q1": nrm(ks[4], (L, A_DK), 0.1),
        "lam_k1": nrm(ks[5], (L, A_DK), 0.1),
        "lam_q2": nrm(ks[6], (L, A_DK), 0.1),
        "lam_k2": nrm(ks[7], (L, A_DK), 0.1),
        "subln_g": gain(ks[8], (L, A_DV)),
        "rel_bias": nrm(ks[9], (L, B_HEADS, 2 * B_MAX_REL + 1), 0.1),
        "w_up_a": nrm(ks[10], (L, A_WIDTH, D_MODEL), A_WIDTH ** -0.5),
        "w_up_b": nrm(ks[11], (L, B_WIDTH, D_MODEL), B_WIDTH ** -0.5),
        "w_out": nrm(ks[12], (L, D_MODEL, D_MODEL), D_MODEL ** -0.5),
        "norm_cross_g": gain(ks[13], (L, D_MODEL)),
        "norm_mem_g": gain(ks[14], (L, D_MODEL)),
        "w_cq": nrm(ks[15], (L, D_MODEL, D_MODEL), D_MODEL ** -0.5),
        "w_ckv": nrm(ks[16], (L, D_MODEL, 2 * D_MODEL), D_MODEL ** -0.5),
        "w_co": nrm(ks[17], (L, D_MODEL, D_MODEL), D_MODEL ** -0.5),
        "norm_ffn_g": gain(ks[18], (L, D_MODEL)),
        "w_gate_up": nrm(ks[19], (L, D_MODEL, 2 * D_FF), D_MODEL ** -0.5),
        "w_down": nrm(ks[20], (L, D_FF, D_MODEL), D_FF ** -0.5),
        "norm_final_g": gain(ks[21], (D_MODEL,)),
    }


def reference(x, mem, norm_mix_g, w_in, lam_q1, lam_k1, lam_q2, lam_k2, subln_g,
              rel_bias, w_up_a, w_up_b, w_out, norm_cross_g, norm_mem_g, w_cq,
              w_ckv, w_co, norm_ffn_g, w_gate_up, w_down, norm_final_g):
    b, s = x.shape[0], x.shape[1]
    cos, sin = rope_tables(s, A_DK)
    cos_a = cos[None, :, None, None, :]
    sin_a = sin[None, :, None, None, :]
    for layer in range(DEPTH):
        lam_init = 0.8 - 0.6 * math.exp(-0.3 * layer)
        h = rmsnorm(x, norm_mix_g[layer])
        z = h @ w_in[layer]
        qa = z[..., OFF_QA:OFF_KA].reshape(b, s, A_HEADS, 2, A_DK)
        ka = z[..., OFF_KA:OFF_VA].reshape(b, s, A_HEADS, 2, A_DK)
        va = z[..., OFF_VA:OFF_QB].reshape(b, s, A_HEADS, A_DV)
        qb = z[..., OFF_QB:OFF_KB].reshape(b, s, B_HEADS, B_DH)
        kb = z[..., OFF_KB:OFF_VB].reshape(b, s, B_HEADS, B_DH)
        vb = z[..., OFF_VB:OFF_GA].reshape(b, s, B_HEADS, B_DH)
        ga = z[..., OFF_GA:OFF_GB]
        gb = z[..., OFF_GB:IN_COLS]
        qa = apply_rope(qa, cos_a, sin_a)
        ka = apply_rope(ka, cos_a, sin_a)
        lam = (jnp.exp(jnp.sum(lam_q1[layer].astype(jnp.float32) * lam_k1[layer].astype(jnp.float32)))
               - jnp.exp(jnp.sum(lam_q2[layer].astype(jnp.float32) * lam_k2[layer].astype(jnp.float32)))
               + lam_init)
        ya = diff_attention(qa, ka, va, lam, subln_g[layer], lam_init)
        yb = chunk_band_attention(qb, kb, vb, rel_bias[layer])
        merged = (jax.nn.sigmoid(ga) * (ya @ w_up_a[layer])
                  + jax.nn.sigmoid(gb) * (yb @ w_up_b[layer]))
        x = x + merged @ w_out[layer]
        hc = rmsnorm(x, norm_cross_g[layer])
        mn = rmsnorm(mem, norm_mem_g[layer])
        x = x + memory_cross_attention(hc, mn, w_cq[layer], w_ckv[layer], w_co[layer])
        hf = rmsnorm(x, norm_ffn_g[layer])
        x = x + swiglu(hf, w_gate_up[layer], w_down[layer])
    return rmsnorm(x, norm_final_g)
```

```cpp
#include <hip/hip_runtime.h>
#include <hip/hip_cooperative_groups.h>
#include <cstdio>
#include <cstdint>
namespace cg = cooperative_groups;

#ifndef ONE_LAUNCH
#define ONE_LAUNCH 1
#endif

#define REP_P0 1
#define REP_P1 1
#define REP_P8 1
#define LAS __attribute__((address_space(3)))
typedef unsigned short bf16_t;
typedef short bf16x8 __attribute__((ext_vector_type(8)));
typedef short s16x4 __attribute__((ext_vector_type(4)));
typedef short v4i16_t __attribute__((ext_vector_type(4)));
typedef float f32x4 __attribute__((ext_vector_type(4)));
typedef float f32x16 __attribute__((ext_vector_type(16)));
typedef unsigned u32x4 __attribute__((ext_vector_type(4)));
typedef unsigned u32x2 __attribute__((ext_vector_type(2)));
typedef float f32x2_t __attribute__((ext_vector_type(2)));
typedef __bf16 bf16x2_t __attribute__((ext_vector_type(2)));

constexpr int BATCH = 16, SEQ = 2048, DM = 1024, MROWS = BATCH * SEQ;
constexpr int NMEM = 256, MEMROWS = BATCH * NMEM;
constexpr int INC = 5120, DFF = 2816, QKVW = 3072, GW = 2048;
constexpr float EPS = 1e-6f;
constexpr float LOG2E = 1.4426950408889634f;

constexpr size_t MiB = 1u << 20;
constexpr size_t WS_CTL = 0;
constexpr size_t WS_STATS = 1 * MiB;
constexpr int ST_RSTD1 = 0, ST_SSQ2 = 32768, ST_SSQ3 = 65536, ST_SSQ4 = 98304, ST_RSTDM = 131072, ST_LAM = 135168,
              ST_COS = 147456, ST_SIN = ST_COS + 65536;
constexpr size_t WS_WIN = 4 * MiB, WS_WUP = 14 * MiB, WS_WOUT = 16 * MiB, WS_WCQ = 18 * MiB, WS_WCKV = 20 * MiB, WS_WCO = 24 * MiB,
                 WS_WGU = 26 * MiB, WS_WD = 37 * MiB;
constexpr size_t WS_KVX = 44 * MiB, WS_MEMB = 60 * MiB;
constexpr size_t WS_XB = 68 * MiB;
constexpr size_t WS_QKV = 132 * MiB;
constexpr size_t WS_T = 132 * MiB, WS_QX = 196 * MiB, WS_OX = 260 * MiB, WS_ACT = 132 * MiB;
constexpr size_t WS_G = 324 * MiB;
constexpr size_t WS_X1B = 324 * MiB, WS_X2B = 388 * MiB;
constexpr size_t WS_END = 452 * MiB;

__device__ __forceinline__ unsigned pk2(float lo, float hi) { f32x2_t v = {lo, hi}; bf16x2_t b = __builtin_convertvector(v, bf16x2_t); return __builtin_bit_cast(unsigned, b); }
__device__ __forceinline__ float bf2f(unsigned short h) { return __builtin_bit_cast(float, (unsigned)h << 16); }
__device__ __forceinline__ float bflo(unsigned w) { return __builtin_bit_cast(float, w << 16); }
__device__ __forceinline__ float bfhi(unsigned w) { return __builtin_bit_cast(float, w & 0xffff0000u); }
__device__ __forceinline__ float fexp2(float x) { return __builtin_amdgcn_exp2f(x); }
__device__ __forceinline__ float frcp(float x) { return __builtin_amdgcn_rcpf(x); }
__device__ __forceinline__ float fsigmoid(float x) { return frcp(1.f + fexp2(-x * LOG2E)); }
__device__ __forceinline__ float wave_sum(float v) {
#pragma unroll
    for (int o = 1; o < 64; o <<= 1) v += __shfl_xor(v, o);
    return v;
}

namespace pg8 {
constexpr int BM = 256, BK = 64, HALF = 128, HTB = HALF * BK * 2, NXCD = 8, WGM = 4;
__host__ __device__ __forceinline__ int lds_byte(int r, int c) { const int st = (r >> 4) * 2 + (c >> 5), rr = r & 15, cc = c & 31, ob = rr * 64 + cc * 2; return st * 1024 + (ob ^ (((ob >> 9) & 1) << 5)); }
__host__ __device__ __forceinline__ void stage_rc(int b, int& R, int& C) { const int st = b / 1024, sb = b % 1024, swz = sb ^ (((sb >> 9) & 1) << 5); R = (st >> 1) * 16 + swz / 64; C = (st & 1) * 32 + (swz % 64) / 2; }
__host__ __device__ __forceinline__ int perm32(int rho) { const int n = rho >> 4, i = rho & 15; return 8 * (i >> 2) + 4 * n + (i & 3); }

struct Unit { int pm, pn; };
struct Gemm { const bf16_t* A; const bf16_t* Bt; int lda, ldb, K; size_t bbatch = 0; };

struct StaticOrder {
    int nM, nN, nwg, G, c;
    __device__ void init(int M, int N, int G_, int c_) { nM = M / BM; nN = N / BM; nwg = nM * nN; G = G_; c = c_; }
    __device__ bool next(int i, Unit& u) const {
        const long L = (long)i * G + c; if (L >= nwg) return false;
        int wgid = (int)L; { const int q = nwg / NXCD, r = nwg % NXCD, xcd = wgid % NXCD, off = wgid / NXCD; wgid = (xcd < r ? xcd * (q + 1) : r * (q + 1) + (xcd - r) * q) + off; }
        const int nig = WGM * nN, gid = wgid / nig, fm = gid * WGM, gsz = (nM - fm) < WGM ? (nM - fm) : WGM;
        u.pm = fm + ((wgid % nig) % gsz); u.pn = (wgid % nig) / gsz; return true;
    }
    __device__ __forceinline__ const char* abase(const Gemm& g, const Unit& u, size_t tA) const { return (const char*)g.A + (size_t)u.pm * tA; }
    __device__ __forceinline__ const char* bbase(const Gemm& g, const Unit& u, size_t tB) const { return (const char*)g.Bt + (size_t)u.pn * tB + (size_t)(u.pm >> 3) * g.bbatch; }
};
template <int mode> struct PreOrder {
    int G, c; const bf16_t* kvx; const bf16_t* w;
    __device__ bool next(int i, Unit& u) const { const int L = i * G + c; if (L >= 256) return false; u.pm = L >> 2; u.pn = L & 3; return true; }
    __device__ __forceinline__ const char* abase(const Gemm&, const Unit& u, size_t) const {
        return mode == 0 ? (const char*)(kvx + (size_t)(u.pm >> 2) * 256 * 2048 + (u.pm & 3) * 256) : (const char*)(w + (size_t)(u.pm & 3) * 256 * 1024 + u.pn * 256); }
    __device__ __forceinline__ const char* bbase(const Gemm&, const Unit& u, size_t) const {
        return mode == 0 ? (const char*)(w + (size_t)u.pn * 256 * 1024 + (u.pm & 3) * 256) : (const char*)(kvx + (size_t)(u.pm >> 2) * 256 * 2048 + 1024 + u.pn * 256); }
};

template <class Epi, bool SPLIT2 = false, bool ALIGN_EPI = true, class Sched = StaticOrder, bool HALF_M = false>
__device__ __forceinline__ void gemm_phase(LAS unsigned char* lds, const Gemm g, const Sched& S, const Epi& E) {
    const int tid = threadIdx.x, wid = __builtin_amdgcn_readfirstlane(tid >> 6), lane = tid & 63, wr = wid >> 2, wc = wid & 3, fr = lane & 15, fq = lane >> 4;
    const int K = g.K, nt = K / BK;
    unsigned voffA[2], voffB[2];
#pragma unroll
    for (int i = 0; i < 2; ++i) { int R, C; stage_rc(tid * 16 + i * 8192, R, C); const int Rb = (R & ~31) + perm32(R & 31);
        voffA[i] = (unsigned)(R * g.lda + C) * 2u; voffB[i] = (unsigned)(Rb * g.ldb + C) * 2u; }
    const size_t kstep = (size_t)(BK * 2);
    const size_t hstepA = HALF_M ? 0 : (size_t)HALF * g.lda * 2, hstepB = (size_t)HALF * g.ldb * 2;
    const size_t tstepA = HALF_M ? (size_t)HALF * g.lda * 2 : 2 * hstepA, tstepB = 2 * hstepB;
    const unsigned ldsw = (unsigned)wid * 1024u;
    const int aoff = lds_byte(wr * 64 + fr, fq * 8), boff = lds_byte(wc * 32 + fr, fq * 8);
#define PG8_SA(b, h) (((b) * 2 + (h)) * HTB)
#define PG8_SB(b, h) ((4 + (b) * 2 + (h)) * HTB)
#define PG8_STAGE(bufoff, gbase, voff) do { _Pragma("unroll") for (int _i = 0; _i < 2; ++_i) \
        __builtin_amdgcn_global_load_lds((const unsigned*)((const char*)(gbase) + (voff)[_i]), (LAS unsigned*)(lds + (bufoff) + ldsw + _i * 8192), 16, 0, 0); } while (0)
#define PG8_LDA(dst, b, h) do { _Pragma("unroll") for (int m = 0; m < 4; ++m) _Pragma("unroll") for (int k = 0; k < 2; ++k) dst[m][k] = *(const LAS bf16x8*)(lds + PG8_SA(b, h) + aoff + m * 2048 + k * 1024); } while (0)
#define PG8_LDB(dst, b, h) do { _Pragma("unroll") for (int n = 0; n < 2; ++n) _Pragma("unroll") for (int k = 0; k < 2; ++k) dst[n][k] = *(const LAS bf16x8*)(lds + PG8_SB(b, h) + boff + n * 2048 + k * 1024); } while (0)
#define PG8_MMA(ai, bj, At, Bt) do { __builtin_amdgcn_s_setprio(1); _Pragma("unroll") for (int m = 0; m < 4; ++m) _Pragma("unroll") for (int n = 0; n < 2; ++n) _Pragma("unroll") for (int k = 0; k < 2; ++k) \
        acc[ai][bj][m][n] = __builtin_amdgcn_mfma_f32_16x16x32_bf16(Bt[n][k], At[m][k], acc[ai][bj][m][n], 0, 0, 0); __builtin_amdgcn_s_setprio(0); } while (0)
#define PG8_WAIT_V(n) asm volatile("s_waitcnt vmcnt(" #n ")" ::: "memory")
#define PG8_WAIT_L(n) asm volatile("s_waitcnt lgkmcnt(" #n ")" ::: "memory")
#define PG8_BAR __builtin_amdgcn_s_barrier()
#define PG8_SCHED __builtin_amdgcn_sched_barrier(0)
    Unit cur, nxt; int ui = 0;
    constexpr int SH = SPLIT2 ? 1 : 0; constexpr size_t SUBSTEP = 1024;
    if (!S.next(0, cur)) return;
    f32x4 acc[2][2][4][2];
#pragma unroll
    for (int a = 0; a < 2; ++a)
#pragma unroll
        for (int b = 0; b < 2; ++b)
#pragma unroll
            for (int m = 0; m < 4; ++m)
#pragma unroll
                for (int n = 0; n < 2; ++n) acc[a][b][m][n] = (f32x4){0.f, 0.f, 0.f, 0.f};
    bf16x8 At[4][2], B0[2][2], B1[2][2];
    const char* cA = S.abase(g, cur, tstepA); const char* cB = S.bbase(g, cur, tstepB);
    PG8_STAGE(PG8_SB(0, 0), cB, voffB); PG8_STAGE(PG8_SB(0, 1), cB + hstepB, voffB); PG8_STAGE(PG8_SA(0, 0), cA, voffA); PG8_STAGE(PG8_SA(0, 1), cA + hstepA, voffA);
    if (wr == 1) PG8_BAR;
    PG8_WAIT_V(2); PG8_BAR;
    PG8_STAGE(PG8_SB(1, 0), cB + kstep, voffB); PG8_STAGE(PG8_SA(1, 0), cA + kstep, voffA); PG8_STAGE(PG8_SB(1, 1), cB + hstepB + kstep, voffB);
    PG8_WAIT_V(6); PG8_BAR;
    for (;;) {
        const bool has_next = S.next((ui + 1) >> SH, nxt);
        const size_t nsub = SPLIT2 ? (size_t)((ui + 1) & 1) * SUBSTEP : 0;
        const char* nA = has_next ? S.abase(g, nxt, tstepA) + nsub : cA; const char* nB = has_next ? S.bbase(g, nxt, tstepB) + nsub : cB;
        for (int t = 0; t < nt; t += 2) {
            const bool last = (t == nt - 2);
            const char* a1 = cA + (size_t)(t + 1) * kstep;
            const char* a2 = last ? nA : cA + (size_t)(t + 2) * kstep; const char* b2 = last ? nB : cB + (size_t)(t + 2) * kstep;
            const char* a3 = a2 + kstep; const char* b3 = b2 + kstep;
            PG8_LDB(B0, 0, 0); PG8_LDB(B1, 0, 1); PG8_SCHED; PG8_LDA(At, 0, 0); PG8_STAGE(PG8_SA(1, 1), a1 + hstepA, voffA);
            PG8_WAIT_V(8); PG8_WAIT_L(0); PG8_BAR; PG8_MMA(0, 0, At, B0); PG8_MMA(0, 1, At, B1); PG8_BAR; PG8_SCHED;
            PG8_LDA(At, 0, 1); PG8_STAGE(PG8_SB(0, 0), b2, voffB); PG8_STAGE(PG8_SB(0, 1), b2 + hstepB, voffB); PG8_STAGE(PG8_SA(0, 0), a2, voffA);
            PG8_WAIT_V(8); PG8_WAIT_L(0); PG8_BAR; if constexpr (!HALF_M) { PG8_MMA(1, 0, At, B0); PG8_MMA(1, 1, At, B1); } PG8_BAR; PG8_SCHED;
            PG8_LDB(B0, 1, 0); PG8_LDB(B1, 1, 1); PG8_SCHED; PG8_LDA(At, 1, 0); PG8_STAGE(PG8_SA(0, 1), a2 + hstepA, voffA);
            PG8_WAIT_V(8); PG8_WAIT_L(0); PG8_BAR; PG8_MMA(0, 0, At, B0); PG8_MMA(0, 1, At, B1); PG8_BAR; PG8_SCHED;
            PG8_LDA(At, 1, 1); PG8_STAGE(PG8_SB(1, 0), b3, voffB); PG8_STAGE(PG8_SB(1, 1), b3 + hstepB, voffB); PG8_STAGE(PG8_SA(1, 0), a3, voffA);
            PG8_WAIT_V(8); PG8_WAIT_L(0); PG8_BAR; if constexpr (!HALF_M) { PG8_MMA(1, 0, At, B0); PG8_MMA(1, 1, At, B1); } PG8_BAR; PG8_SCHED;
        }
        if constexpr (ALIGN_EPI) { if (wr == 0) PG8_BAR; }
        if constexpr (SPLIT2) { if (!(ui & 1)) E.first(acc, cur, wr, wc, fr, fq); else E(acc, cur, wr, wc, fr, fq); }
        else E(acc, cur, wr, wc, fr, fq);
        if (!has_next) break;
#pragma unroll
        for (int a = 0; a < 2; ++a)
#pragma unroll
            for (int b = 0; b < 2; ++b)
#pragma unroll
                for (int m = 0; m < 4; ++m)
#pragma unroll
                    for (int n = 0; n < 2; ++n) acc[a][b][m][n] = (f32x4){0.f, 0.f, 0.f, 0.f};
        cur = nxt; cA = nA; cB = nB; ++ui;
        if constexpr (ALIGN_EPI) { if (wr == 1) PG8_BAR; }
    }
    PG8_WAIT_V(0);
    if constexpr (!ALIGN_EPI) { if (wr == 0) PG8_BAR; }
    PG8_BAR;
#undef PG8_SA
#undef PG8_SB
#undef PG8_STAGE
#undef PG8_LDA
#undef PG8_LDB
#undef PG8_MMA
#undef PG8_WAIT_V
#undef PG8_WAIT_L
#undef PG8_BAR
#undef PG8_SCHED
}

#define EPI_LOAD_ROWSCALE(dst, ptr) float dst[2][4]; { const int _r0 = u.pm * BM + wr * 64 + fr; \
    _Pragma("unroll") for (int _a = 0; _a < 2; ++_a) _Pragma("unroll") for (int _m = 0; _m < 4; ++_m) dst[_a][_m] = (ptr)[_r0 + _a * HALF + _m * 16]; \
    asm volatile("s_waitcnt vmcnt(0)" ::: "memory"); \
    _Pragma("unroll") for (int _a = 0; _a < 2; ++_a) _Pragma("unroll") for (int _m = 0; _m < 4; ++_m) asm volatile("" : "+v"(dst[_a][_m])); }
#define EPI_ROWS_BEGIN const int row0 = u.pm * BM + wr * 64 + fr; const int cb = u.pn * BM + wc * 32 + 8 * fq; \
    _Pragma("unroll") for (int ai = 0; ai < 2; ++ai) _Pragma("unroll") for (int m = 0; m < 4; ++m) { const int row = row0 + ai * HALF + m * 16;

__device__ __forceinline__ u32x4 pack8(f32x4 v0, f32x4 v1) { u32x4 w; w.x = pk2(v0[0], v0[1]); w.y = pk2(v0[2], v0[3]); w.z = pk2(v1[0], v1[1]); w.w = pk2(v1[2], v1[3]); return w; }

struct EpiZ {
    bf16_t* QKV; bf16_t* G; const float* rstd; const float* cosT; const float* sinT; int pn0;
    __device__ __forceinline__ void operator()(const f32x4 (&acc)[2][2][4][2], const Unit& u0, int wr, int wc, int fr, int fq) const {
        Unit u; u.pm = u0.pm; u.pn = u0.pn + pn0;
        EPI_LOAD_ROWSCALE(rsv, rstd)
        EPI_ROWS_BEGIN
            const float rs = rsv[ai][m]; const int pos = row & (SEQ - 1);
#pragma unroll
            for (int bj = 0; bj < 2; ++bj) { const int c = cb + bj * HALF; f32x4 v0 = acc[ai][bj][m][0] * rs, v1 = acc[ai][bj][m][1] * rs;
                if (u.pn < 4) {
                    const int i0 = (c & 63) >> 1;
                    const f32x4 cs = *(const f32x4*)(cosT + pos * 32 + i0), sn = *(const f32x4*)(sinT + pos * 32 + i0);
                    f32x4 r0, r1;
                    r0[0] = v0[0] * cs[0] - v0[1] * sn[0]; r0[1] = v0[1] * cs[0] + v0[0] * sn[0];
                    r0[2] = v0[2] * cs[1] - v0[3] * sn[1]; r0[3] = v0[3] * cs[1] + v0[2] * sn[1];
                    r1[0] = v1[0] * cs[2] - v1[1] * sn[2]; r1[1] = v1[1] * cs[2] + v1[0] * sn[2];
                    r1[2] = v1[2] * cs[3] - v1[3] * sn[3]; r1[3] = v1[3] * cs[3] + v1[2] * sn[3];
                    v0 = r0; v1 = r1;
                }
                if (u.pn < 12) { *(u32x4*)(QKV + (size_t)row * QKVW + c) = pack8(v0, v1); }
                else {
#pragma unroll
                    for (int e = 0; e < 4; ++e) { v0[e] = fsigmoid(v0[e]); v1[e] = fsigmoid(v1[e]); }
                    *(u32x4*)(G + (size_t)row * GW + (c - QKVW)) = pack8(v0, v1);
                }
            }
        }
    }
};

template <bool FROM_SSQ> struct EpiScale {
    bf16_t* O; int ldc; const float* rs; float cs = 1.f;
    __device__ __forceinline__ void operator()(const f32x4 (&acc)[2][2][4][2], const Unit& u, int wr, int wc, int fr, int fq) const {
        EPI_ROWS_BEGIN
            float s = cs; if (rs) { s = rs[row]; if (FROM_SSQ) s = __builtin_amdgcn_rsqf(s * (1.f / DM) + EPS); }
#pragma unroll
            for (int bj = 0; bj < 2; ++bj) { const int c = cb + bj * HALF;
                *(u32x4*)(O + (size_t)row * ldc + c) = pack8(acc[ai][bj][m][0] * s, acc[ai][bj][m][1] * s); }
        }
    }
};


struct EpiScaleHalf {
    bf16_t* O; int ldc; const float* rs;
    __device__ __forceinline__ void operator()(const f32x4 (&acc)[2][2][4][2], const Unit& u, int wr, int wc, int fr, int fq) const {
        const int row0 = u.pm * HALF + wr * 64 + fr; const int cb = u.pn * BM + wc * 32 + 8 * fq;
        float sv[4];
#pragma unroll
        for (int m = 0; m < 4; ++m) sv[m] = rs[row0 + m * 16];
        asm volatile("s_waitcnt vmcnt(0)" ::: "memory");
#pragma unroll
        for (int m = 0; m < 4; ++m) asm volatile("" : "+v"(sv[m]));
#pragma unroll
        for (int m = 0; m < 4; ++m) { const int row = row0 + m * 16; const float s = sv[m];
#pragma unroll
            for (int bj = 0; bj < 2; ++bj) { const int c = cb + bj * HALF;
                *(u32x4*)(O + (size_t)row * ldc + c) = pack8(acc[0][bj][m][0] * s, acc[0][bj][m][1] * s); }
        }
    }
};

struct EpiGateMerged {
    bf16_t* T; const bf16_t* G;
    template <bool SECOND> __device__ __forceinline__ void run(const f32x4 (&acc)[2][2][4][2], const Unit& u, int wr, int wc, int fr, int fq) const {
        const int row0 = u.pm * BM + wr * 64 + fr; const int cb = u.pn * BM + wc * 32 + 8 * fq;
#pragma unroll
        for (int ai = 0; ai < 2; ++ai)
#pragma unroll
        for (int mh = 0; mh < 2; ++mh) {
            u32x4 gv[2][2], tv[2][2];
#pragma unroll
            for (int mm = 0; mm < 2; ++mm)
#pragma unroll
                for (int bj = 0; bj < 2; ++bj) { const int row = row0 + ai * HALF + (2 * mh + mm) * 16, c = cb + bj * HALF;
                    gv[mm][bj] = *(const u32x4*)(G + (size_t)row * GW + (SECOND ? DM : 0) + c);
                    if (SECOND) tv[mm][bj] = *(const u32x4*)(T + (size_t)row * DM + c); }
            asm volatile("s_waitcnt vmcnt(0)" ::: "memory");
#pragma unroll
            for (int mm = 0; mm < 2; ++mm)
#pragma unroll
                for (int bj = 0; bj < 2; ++bj) { asm volatile("" : "+v"(gv[mm][bj])); if (SECOND) asm volatile("" : "+v"(tv[mm][bj])); }
#pragma unroll
            for (int mm = 0; mm < 2; ++mm)
#pragma unroll
                for (int bj = 0; bj < 2; ++bj) { const int m = 2 * mh + mm; const int row = row0 + ai * HALF + m * 16, c = cb + bj * HALF;
                    const u32x4 gw = gv[mm][bj];
                    const f32x4 g0 = {bflo(gw.x), bfhi(gw.x), bflo(gw.y), bfhi(gw.y)}, g1 = {bflo(gw.z), bfhi(gw.z), bflo(gw.w), bfhi(gw.w)};
                    f32x4 v0 = acc[ai][bj][m][0] * g0, v1 = acc[ai][bj][m][1] * g1;
                    if (SECOND) { const u32x4 tw = tv[mm][bj];
                        v0 += (f32x4){bflo(tw.x), bfhi(tw.x), bflo(tw.y), bfhi(tw.y)}; v1 += (f32x4){bflo(tw.z), bfhi(tw.z), bflo(tw.w), bfhi(tw.w)}; }
                    *(u32x4*)(T + (size_t)row * DM + c) = pack8(v0, v1); }
        }
    }
    __device__ __forceinline__ void first(const f32x4 (&acc)[2][2][4][2], const Unit& u, int wr, int wc, int fr, int fq) const { run<false>(acc, u, wr, wc, fr, fq); }
    __device__ __forceinline__ void operator()(const f32x4 (&acc)[2][2][4][2], const Unit& u, int wr, int wc, int fr, int fq) const { run<true>(acc, u, wr, wc, fr, fq); }
};

template <bool XIN_F32> struct EpiResid {
    const float* xin; const bf16_t* xinb; bf16_t* xb; float* ssq;
    __device__ __forceinline__ void operator()(const f32x4 (&acc)[2][2][4][2], const Unit& u, int wr, int wc, int fr, int fq) const {
        const int row0 = u.pm * BM + wr * 64 + fr; const int cb = u.pn * BM + wc * 32 + 8 * fq;
#pragma unroll
        for (int ai = 0; ai < 2; ++ai) {
            f32x4 xv[4][2][2];
#pragma unroll
            for (int m = 0; m < 4; ++m)
#pragma unroll
                for (int bj = 0; bj < 2; ++bj) { const size_t o = (size_t)(row0 + ai * HALF + m * 16) * DM + cb + bj * HALF;
                    if (XIN_F32) { xv[m][bj][0] = *(const f32x4*)(xin + o); xv[m][bj][1] = *(const f32x4*)(xin + o + 4); }
                    else { const u32x4 w = *(const u32x4*)(xinb + o); xv[m][bj][0] = __builtin_bit_cast(f32x4, w); } }
            asm volatile("s_waitcnt vmcnt(0)" ::: "memory");
#pragma unroll
            for (int m = 0; m < 4; ++m)
#pragma unroll
                for (int bj = 0; bj < 2; ++bj) { asm volatile("" : "+v"(xv[m][bj][0])); if (XIN_F32) asm volatile("" : "+v"(xv[m][bj][1])); }
#pragma unroll
            for (int m = 0; m < 4; ++m) { const int row = row0 + ai * HALF + m * 16;
                float ss = 0.f;
#pragma unroll
                for (int bj = 0; bj < 2; ++bj) { const size_t o = (size_t)row * DM + cb + bj * HALF;
                    f32x4 v0, v1;
                    if (XIN_F32) { v0 = xv[m][bj][0]; v1 = xv[m][bj][1]; }
                    else { const u32x4 w = __builtin_bit_cast(u32x4, xv[m][bj][0]); v0 = (f32x4){bflo(w.x), bfhi(w.x), bflo(w.y), bfhi(w.y)}; v1 = (f32x4){bflo(w.z), bfhi(w.z), bflo(w.w), bfhi(w.w)}; }
                    v0 += acc[ai][bj][m][0]; v1 += acc[ai][bj][m][1];
                    *(u32x4*)(xb + o) = pack8(v0, v1);
                    ss += (v0[0] * v0[0] + v0[1] * v0[1]) + (v0[2] * v0[2] + v0[3] * v0[3]) + (v1[0] * v1[0] + v1[1] * v1[1]) + (v1[2] * v1[2] + v1[3] * v1[3]); }
                ss += __shfl_xor(ss, 16); ss += __shfl_xor(ss, 32);
                if (fq == 0) unsafeAtomicAdd(ssq + row, ss);
            }
        }
    }
};


struct EpiSoftmax {
    bf16_t* P; const float* ssq; LAS float* red;
    __device__ __forceinline__ void operator()(f32x4 (&acc)[2][2][4][2], const Unit& u, int wr, int wc, int fr, int fq) const {
        float mrow[2][4];
        EPI_LOAD_ROWSCALE(ssv, ssq)
        { EPI_ROWS_BEGIN
            (void)row; const float s = __builtin_amdgcn_rsqf(ssv[ai][m] * (1.f / DM) + EPS);
            float mx = -1e30f;
#pragma unroll
            for (int bj = 0; bj < 2; ++bj)
#pragma unroll
                for (int n = 0; n < 2; ++n) { acc[ai][bj][m][n] *= s;
#pragma unroll
                    for (int e = 0; e < 4; ++e) mx = fmaxf(mx, acc[ai][bj][m][n][e]); }
            mx = fmaxf(mx, __shfl_xor(mx, 16)); mx = fmaxf(mx, __shfl_xor(mx, 32));
            mrow[ai][m] = mx;
            if (fq == 0) red[(ai * HALF + wr * 64 + m * 16 + fr) * 4 + wc] = mx;
        } }
        __syncthreads();
        { EPI_ROWS_BEGIN
            (void)row;
            const f32x4 r4 = *(const LAS f32x4*)(red + (ai * HALF + wr * 64 + m * 16 + fr) * 4);
            const float mx = fmaxf(fmaxf(r4[0], r4[1]), fmaxf(r4[2], r4[3]));
            float sum = 0.f;
#pragma unroll
            for (int bj = 0; bj < 2; ++bj)
#pragma unroll
                for (int n = 0; n < 2; ++n)
#pragma unroll
                    for (int e = 0; e < 4; ++e) { const float p = fexp2(acc[ai][bj][m][n][e] - mx); acc[ai][bj][m][n][e] = p; sum += p; }
            sum += __shfl_xor(sum, 16); sum += __shfl_xor(sum, 32);
            mrow[ai][m] = sum;
            if (fq == 0) red[1024 + (ai * HALF + wr * 64 + m * 16 + fr) * 4 + wc] = sum;
        } }
        __syncthreads();
        { EPI_ROWS_BEGIN
            const f32x4 r4 = *(const LAS f32x4*)(red + 1024 + (ai * HALF + wr * 64 + m * 16 + fr) * 4);
            const float inv = frcp((r4[0] + r4[1]) + (r4[2] + r4[3]));
#pragma unroll
            for (int bj = 0; bj < 2; ++bj) { const int c = cb + bj * HALF;
                *(u32x4*)(P + (size_t)row * DM + c) = pack8(acc[ai][bj][m][0] * inv, acc[ai][bj][m][1] * inv); }
        } }
    }
};

struct EpiSwiGLU {
    bf16_t* ACT; const float* ssq;
    __device__ __forceinline__ void operator()(const f32x4 (&acc)[2][2][4][2], const Unit& u, int wr, int wc, int fr, int fq) const {
        EPI_LOAD_ROWSCALE(ssv, ssq)
        EPI_ROWS_BEGIN
            (void)row; const float s = __builtin_amdgcn_rsqf(ssv[ai][m] * (1.f / DM) + EPS);
#pragma unroll
            for (int bj = 0; bj < 2; ++bj) { const int c = cb + bj * HALF;
                const f32x4 v0 = acc[ai][bj][m][0] * s, v1 = acc[ai][bj][m][1] * s;
                const float a0 = v0[0] * fsigmoid(v0[0]) * v0[1], a1 = v0[2] * fsigmoid(v0[2]) * v0[3];
                const float a2 = v1[0] * fsigmoid(v1[0]) * v1[1], a3 = v1[2] * fsigmoid(v1[2]) * v1[3];
                u32x2 w; w.x = pk2(a0, a1); w.y = pk2(a2, a3);
                *(u32x2*)(ACT + (size_t)row * DFF + (c >> 1)) = w; }
        }
    }
};
}

namespace fa {
constexpr int BIAS_OFF = 98304, BIAS_COPY_N = 644, BIAS_COPY_BYTES = BIAS_COPY_N * 4;
#define MFMA32(a, b, c) __builtin_amdgcn_mfma_f32_32x32x16_bf16((a), (b), (c), 0, 0, 0)
__device__ __forceinline__ s16x4 vtr(LAS const unsigned char* p) { return __builtin_bit_cast(s16x4, __builtin_amdgcn_ds_read_tr16_b64_v4i16((LAS v4i16_t*)p)); }

template <int DQK, int DV, int MODE, bool QREG>
__device__ __forceinline__ void flash_pass(LAS unsigned char* lds, const bf16_t* Qw, int ldq, const bf16_t* Kb, int ldk, const bf16_t* Vb, int ldv,
                                           int t_lo, int t_hi, int w_lo, int w_hi, float csc, int qpos_w, f32x16 (&O)[DV / 32]) {
    constexpr int KP2 = (DQK + 8) * 2, VP2 = (DV + 32) * 2;
    constexpr int VOFF = 64 * KP2, BUFB = VOFF + 64 * VP2;
    static_assert(2 * BUFB <= BIAS_OFF, "stage buffers below the bias table");
    constexpr int KCH = DQK / 8, KN = 64 * KCH / 512, VCH = DV / 8, VN = 64 * VCH / 512;
    const int tid = threadIdx.x, lane = tid & 63, l31 = lane & 31, h = lane >> 5;
    const LAS float* bl = (const LAS float*)(lds + BIAS_OFF);
    bf16x8 Qf[QREG ? DQK / 16 : 1];
    const bf16_t* qbase = Qw + (size_t)l31 * ldq + h * 8;
    if (QREG) {
#pragma unroll
        for (int ks = 0; ks < DQK / 16; ++ks) Qf[ks] = *(const bf16x8*)(qbase + ks * 16);
    }
#pragma unroll
    for (int d = 0; d < DV / 32; ++d)
#pragma unroll
        for (int r = 0; r < 16; ++r) O[d][r] = 0.f;
    float mused = -1e30f, lsum = 0.f;
    u32x4 kreg[KN], vreg[VN];
#define FA_LOAD(t) do { \
        _Pragma("unroll") for (int i = 0; i < KN; ++i) { const int cid = tid + i * 512, r = cid / KCH, cc = cid % KCH; kreg[i] = *(const u32x4*)(Kb + (size_t)((t) * 64 + r) * ldk + cc * 8); } \
        _Pragma("unroll") for (int i = 0; i < VN; ++i) { const int cid = tid + i * 512, r = cid / VCH, cc = cid % VCH; vreg[i] = *(const u32x4*)(Vb + (size_t)((t) * 64 + r) * ldv + cc * 8); } } while (0)
#define FA_STORE(b) do { LAS unsigned char* _kb = lds + (b) * BUFB; \
        _Pragma("unroll") for (int i = 0; i < KN; ++i) { const int cid = tid + i * 512, r = cid / KCH, cc = cid % KCH; *(LAS u32x4*)(_kb + r * KP2 + cc * 16) = kreg[i]; } \
        _Pragma("unroll") for (int i = 0; i < VN; ++i) { const int cid = tid + i * 512, r = cid / VCH, cc = cid % VCH; *(LAS u32x4*)(_kb + VOFF + r * VP2 + cc * 16) = vreg[i]; } } while (0)
    FA_LOAD(t_lo);
    const int q4 = (lane & 15) >> 2, p4 = lane & 3, g16 = (lane >> 4) & 1;
    const int kp_off = l31 * KP2 + h * 16;
    const int vp_off = VOFF + (4 * h + q4) * VP2 + (16 * g16 + 4 * p4) * 2;
    FA_STORE(0);
    if (t_lo + 1 < t_hi) FA_LOAD(t_lo + 1);
    __syncthreads();
    for (int t = t_lo; t < t_hi; ++t) {
        const int cur = (t - t_lo) & 1;
        if (t + 1 < t_hi) { FA_STORE(cur ^ 1); if (t + 2 < t_hi) FA_LOAD(t + 2); }
        if (t >= w_lo && t < w_hi) {
            const LAS unsigned char* kp = lds + cur * BUFB + kp_off;
            const LAS unsigned char* vp = lds + cur * BUFB + vp_off;
            f32x16 s0, s1;
#pragma unroll
            for (int r = 0; r < 16; ++r) { s0[r] = 0.f; s1[r] = 0.f; }
            const bf16_t* qp = qbase;
            if (!QREG) asm volatile("" : "+v"(qp));
#pragma unroll
            for (int ks = 0; ks < DQK / 16; ++ks) {
                const bf16x8 a0 = *(const LAS bf16x8*)(kp + ks * 32);
                const bf16x8 a1 = *(const LAS bf16x8*)(kp + 32 * KP2 + ks * 32);
                const bf16x8 qf = QREG ? Qf[ks] : *(const bf16x8*)(qp + ks * 16);
                s0 = MFMA32(a0, qf, s0); s1 = MFMA32(a1, qf, s1);
            }
            float mx;
            if (MODE == 1) {
                const int rel0 = qpos_w + l31 - (t * 64 + 4 * h);
                if (qpos_w - (t * 64 + 63) >= 256) { const float bc = bl[512];
#pragma unroll
                    for (int r = 0; r < 16; ++r) { s0[r] = s0[r] * csc + bc; s1[r] = s1[r] * csc + bc; }
                } else {
#pragma unroll
                    for (int r = 0; r < 16; ++r) {
                        int i0 = rel0 - 8 * (r >> 2) - (r & 3); int i1 = i0 - 32;
                        i0 = min(max(i0, -256), 256) + 256; i1 = min(max(i1, -256), 256) + 256;
                        s0[r] = s0[r] * csc + bl[i0]; s1[r] = s1[r] * csc + bl[i1]; }
                }
                mx = fmaxf(s0[0], s1[0]);
#pragma unroll
                for (int r = 1; r < 16; ++r) mx = fmaxf(mx, fmaxf(s0[r], s1[r]));
            } else {
                mx = fmaxf(s0[0], s1[0]);
#pragma unroll
                for (int r = 1; r < 16; ++r) mx = fmaxf(mx, fmaxf(s0[r], s1[r]));
                mx *= csc;
            }
            mx = fmaxf(mx, __shfl_xor(mx, 32));
            if (__any(mx > mused + 8.f)) {
                const float mn = fmaxf(mused, mx), alpha = fexp2(mused - mn); mused = mn; lsum *= alpha;
#pragma unroll
                for (int d = 0; d < DV / 32; ++d)
#pragma unroll
                    for (int r = 0; r < 16; ++r) O[d][r] *= alpha;
            }
            float rs = 0.f;
            if (MODE == 1) {
#pragma unroll
                for (int r = 0; r < 16; ++r) { s0[r] = fexp2(s0[r] - mused); s1[r] = fexp2(s1[r] - mused); rs += s0[r] + s1[r]; }
            } else {
                const float nm = -mused;
#pragma unroll
                for (int r = 0; r < 16; ++r) { s0[r] = fexp2(__builtin_fmaf(s0[r], csc, nm)); s1[r] = fexp2(__builtin_fmaf(s1[r], csc, nm)); rs += s0[r] + s1[r]; }
            }
            lsum += rs;
            bf16x8 pb[4];
#pragma unroll
            for (int sp = 0; sp < 2; ++sp) {
                u32x4 w0, w1;
                w0.x = pk2(s0[8 * sp + 0], s0[8 * sp + 1]); w0.y = pk2(s0[8 * sp + 2], s0[8 * sp + 3]); w0.z = pk2(s0[8 * sp + 4], s0[8 * sp + 5]); w0.w = pk2(s0[8 * sp + 6], s0[8 * sp + 7]);
                w1.x = pk2(s1[8 * sp + 0], s1[8 * sp + 1]); w1.y = pk2(s1[8 * sp + 2], s1[8 * sp + 3]); w1.z = pk2(s1[8 * sp + 4], s1[8 * sp + 5]); w1.w = pk2(s1[8 * sp + 6], s1[8 * sp + 7]);
                pb[sp] = __builtin_bit_cast(bf16x8, w0); pb[2 + sp] = __builtin_bit_cast(bf16x8, w1);
            }
#pragma unroll
            for (int ks = 0; ks < 4; ++ks) {
#pragma unroll
                for (int d = 0; d < DV / 32; ++d) {
                    const s16x4 r0 = vtr(vp + (16 * ks) * VP2 + d * 64);
                    const s16x4 r1 = vtr(vp + (16 * ks + 8) * VP2 + d * 64);
                    const bf16x8 vf = {r0[0], r0[1], r0[2], r0[3], r1[0], r1[1], r1[2], r1[3]};
                    O[d] = MFMA32(vf, pb[ks], O[d]);
                }
            }
        }
        __syncthreads();
    }
#undef FA_LOAD
#undef FA_STORE
    lsum += __shfl_xor(lsum, 32);
    const float inv = 1.f / lsum;
#pragma unroll
    for (int d = 0; d < DV / 32; ++d)
#pragma unroll
        for (int r = 0; r < 16; ++r) O[d][r] *= inv;
}


template <int DV, int MODE>
__device__ __forceinline__ void flash_pass_dma(LAS unsigned char* lds, const bf16_t* Qw, int ldq, const bf16_t* Kb, int ldk, const bf16_t* Vb, int ldv,
                                               int t_lo, int t_hi, int w_lo, int w_hi, float csc, int qpos_w, f32x16 (&O)[DV / 32]) {
    constexpr int KBYTES = 8192, VROW = DV * 2, BUF = KBYTES + 64 * VROW, VOPS = DV / 64, OPS = 1 + VOPS;
    static_assert(4 * BUF <= BIAS_OFF, "ring below the bias table");
    const int tid = threadIdx.x, lane = tid & 63, l31 = lane & 31, h = lane >> 5, wave = __builtin_amdgcn_readfirstlane(tid >> 6);
    const LAS float* bl = (const LAS float*)(lds + BIAS_OFF);
    bf16x8 Qf[4];
    const bf16_t* qbase = Qw + (size_t)l31 * ldq + h * 8;
#pragma unroll
    for (int ks = 0; ks < 4; ++ks) Qf[ks] = *(const bf16x8*)(qbase + ks * 16);
#pragma unroll
    for (int d = 0; d < DV / 32; ++d)
#pragma unroll
        for (int r = 0; r < 16; ++r) O[d][r] = 0.f;
    float mused = -1e30f, lsum = 0.f;
    unsigned koff, voff[VOPS];
    { const int r = 8 * wave + (lane >> 3), p = lane & 7, c = p ^ ((r >> 1) & 7); koff = (unsigned)(r * ldk + c * 8); }
    if (DV == 128) {
#pragma unroll
        for (int i = 0; i < VOPS; ++i) { const int j = wave * 2 + i, r = 4 * j + (lane >> 4), p = lane & 15, c = p ^ ((r & 3) << 2); voff[i] = (unsigned)(r * ldv + c * 8); }
    } else { const int r = 8 * wave + (lane >> 3), p = lane & 7, c = p ^ (((r >> 1) & 1) << 2); voff[0] = (unsigned)(r * ldv + c * 8); }
#define FD_ISSUE(t, b) do { \
        __builtin_amdgcn_global_load_lds((const unsigned*)(Kb + (size_t)(t) * 64 * ldk + koff), (LAS unsigned*)(lds + (b) * BUF + wave * 1024), 16, 0, 0); \
        _Pragma("unroll") for (int i = 0; i < VOPS; ++i) __builtin_amdgcn_global_load_lds((const unsigned*)(Vb + (size_t)(t) * 64 * ldv + voff[i]), (LAS unsigned*)(lds + (b) * BUF + KBYTES + (wave * VOPS + i) * 1024), 16, 0, 0); } while (0)
    asm volatile("s_waitcnt vmcnt(0)" ::: "memory");
#pragma unroll
    for (int ks = 0; ks < 4; ++ks) asm volatile("" : "+v"(Qf[ks]));
    __builtin_amdgcn_s_barrier();
    asm volatile("" ::: "memory");
    FD_ISSUE(t_lo, 0);
    if (t_lo + 1 < t_hi) FD_ISSUE(t_lo + 1, 1);
    if (t_lo + 2 < t_hi) FD_ISSUE(t_lo + 2, 2);
    const int q4 = (lane & 15) >> 2, p4 = lane & 3, g16 = (lane >> 4) & 1;
    const int yk = (h ^ ((l31 >> 1) & 7)) << 4;
    const int kp_off = l31 * 128;
    const int vp_off = KBYTES + (4 * h + q4) * VROW + g16 * 32 + p4 * 8;
    const int vx = (DV == 128) ? (q4 * 64) : (((q4 >> 1) & 1) * 64);
#pragma unroll 1
    for (int t = t_lo; t < t_hi; ++t) {
        const int rem = t_hi - 1 - t;
        if (rem >= 2) { if (OPS == 3) asm volatile("s_waitcnt vmcnt(6)" ::: "memory"); else asm volatile("s_waitcnt vmcnt(4)" ::: "memory"); }
        else if (rem == 1) { if (OPS == 3) asm volatile("s_waitcnt vmcnt(3)" ::: "memory"); else asm volatile("s_waitcnt vmcnt(2)" ::: "memory"); }
        else asm volatile("s_waitcnt vmcnt(0)" ::: "memory");
        asm volatile("s_waitcnt lgkmcnt(0)" ::: "memory");
        __builtin_amdgcn_s_barrier();
        asm volatile("" ::: "memory");
        if (t + 3 < t_hi) FD_ISSUE(t + 3, (t + 3 - t_lo) & 3);
        if (t >= w_lo && t < w_hi) {
            const LAS unsigned char* bufp = lds + ((t - t_lo) & 3) * BUF;
            const LAS unsigned char* kp = bufp + kp_off;
            const LAS unsigned char* vp = bufp + vp_off;
            f32x16 s0, s1;
#pragma unroll
            for (int r = 0; r < 16; ++r) { s0[r] = 0.f; s1[r] = 0.f; }
#pragma unroll
            for (int ks = 0; ks < 4; ++ks) {
                const bf16x8 a0 = *(const LAS bf16x8*)(kp + ((ks * 32) ^ yk));
                const bf16x8 a1 = *(const LAS bf16x8*)(kp + 32 * 128 + ((ks * 32) ^ yk));
                s0 = MFMA32(a0, Qf[ks], s0); s1 = MFMA32(a1, Qf[ks], s1);
            }
            float mx;
            if (MODE == 1) {
                const int V00 = 575 - (qpos_w + l31 - (t * 64 + 4 * h));
                const LAS unsigned char* bp = (const LAS unsigned char*)bl + (V00 & 3) * BIAS_COPY_BYTES + (V00 & ~3) * 4;
#pragma unroll
                for (int j = 0; j < 4; ++j) {
                    const f32x4 b0 = *(const LAS f32x4*)(bp + (8 * j) * 4), b1 = *(const LAS f32x4*)(bp + (32 + 8 * j) * 4);
#pragma unroll
                    for (int i = 0; i < 4; ++i) { s0[4 * j + i] = s0[4 * j + i] * csc + b0[i]; s1[4 * j + i] = s1[4 * j + i] * csc + b1[i]; }
                }
                mx = fmaxf(s0[0], s1[0]);
#pragma unroll
                for (int r = 1; r < 16; ++r) mx = fmaxf(mx, fmaxf(s0[r], s1[r]));
            } else {
                mx = fmaxf(s0[0], s1[0]);
#pragma unroll
                for (int r = 1; r < 16; ++r) mx = fmaxf(mx, fmaxf(s0[r], s1[r]));
                mx *= csc;
            }
            mx = fmaxf(mx, __shfl_xor(mx, 32));
            if (__any(mx > mused + 8.f)) {
                const float mn = fmaxf(mused, mx), alpha = fexp2(mused - mn); mused = mn; lsum *= alpha;
#pragma unroll
                for (int d = 0; d < DV / 32; ++d)
#pragma unroll
                    for (int r = 0; r < 16; ++r) O[d][r] *= alpha;
            }
            float rs = 0.f;
            if (MODE == 1) {
#pragma unroll
                for (int r = 0; r < 16; ++r) { s0[r] = fexp2(s0[r] - mused); s1[r] = fexp2(s1[r] - mused); rs += s0[r] + s1[r]; }
            } else {
                const float nm = -mused;
#pragma unroll
                for (int r = 0; r < 16; ++r) { s0[r] = fexp2(__builtin_fmaf(s0[r], csc, nm)); s1[r] = fexp2(__builtin_fmaf(s1[r], csc, nm)); rs += s0[r] + s1[r]; }
            }
            lsum += rs;
            bf16x8 pb[4];
#pragma unroll
            for (int sp = 0; sp < 2; ++sp) {
                u32x4 w0, w1;
                w0.x = pk2(s0[8 * sp + 0], s0[8 * sp + 1]); w0.y = pk2(s0[8 * sp + 2], s0[8 * sp + 3]); w0.z = pk2(s0[8 * sp + 4], s0[8 * sp + 5]); w0.w = pk2(s0[8 * sp + 6], s0[8 * sp + 7]);
                w1.x = pk2(s1[8 * sp + 0], s1[8 * sp + 1]); w1.y = pk2(s1[8 * sp + 2], s1[8 * sp + 3]); w1.z = pk2(s1[8 * sp + 4], s1[8 * sp + 5]); w1.w = pk2(s1[8 * sp + 6], s1[8 * sp + 7]);
                pb[sp] = __builtin_bit_cast(bf16x8, w0); pb[2 + sp] = __builtin_bit_cast(bf16x8, w1);
            }
#pragma unroll
            for (int ks = 0; ks < 4; ++ks) {
#pragma unroll
                for (int d = 0; d < DV / 32; ++d) {
                    const s16x4 r0 = vtr(vp + (16 * ks) * VROW + ((d * 64) ^ vx));
                    const s16x4 r1 = vtr(vp + (16 * ks + 8) * VROW + ((d * 64) ^ vx));
                    const bf16x8 vf = {r0[0], r0[1], r0[2], r0[3], r1[0], r1[1], r1[2], r1[3]};
                    O[d] = MFMA32(vf, pb[ks], O[d]);
                }
            }
        }
    }
#undef FD_ISSUE
    lsum += __shfl_xor(lsum, 32);
    const float inv = 1.f / lsum;
#pragma unroll
    for (int d = 0; d < DV / 32; ++d)
#pragma unroll
        for (int r = 0; r < 16; ++r) O[d][r] *= inv;
}


__device__ __forceinline__ void cross_pass(LAS unsigned char* lds, const bf16_t* Qw, const bf16_t* Kb, const bf16_t* Vb, float csc, f32x16 (&O)[4]) {
    constexpr int LDK = 2048, KBYTES = 32768, BUF = 49152;
    const int tid = threadIdx.x, lane = tid & 63, l31 = lane & 31, h = lane >> 5, wave = __builtin_amdgcn_readfirstlane(tid >> 6);
    bf16x8 Qf[16];
    const bf16_t* qbase = Qw + (size_t)l31 * DM + h * 8;
#pragma unroll
    for (int ks = 0; ks < 16; ++ks) Qf[ks] = *(const bf16x8*)(qbase + ks * 16);
#pragma unroll
    for (int d = 0; d < 4; ++d)
#pragma unroll
        for (int r = 0; r < 16; ++r) O[d][r] = 0.f;
    float mused = -1e30f, lsum = 0.f;
    unsigned koff[4], voff[2];
#pragma unroll
    for (int i = 0; i < 4; ++i) { const int j = wave * 4 + i, r = 2 * j + (lane >> 5), p = lane & 31, c = p ^ (r & 31); koff[i] = (unsigned)(r * LDK + c * 8); }
#pragma unroll
    for (int i = 0; i < 2; ++i) { const int j = wave * 2 + i, r = 4 * j + (lane >> 4), p = lane & 15, c = p ^ ((r & 3) << 2); voff[i] = (unsigned)(r * LDK + c * 8); }
#define CX_ISSUE(t, b) do { \
        _Pragma("unroll") for (int i = 0; i < 4; ++i) __builtin_amdgcn_global_load_lds((const unsigned*)(Kb + (size_t)(t) * 64 * LDK + koff[i]), (LAS unsigned*)(lds + (b) * BUF + (wave * 4 + i) * 1024), 16, 0, 0); \
        _Pragma("unroll") for (int i = 0; i < 2; ++i) __builtin_amdgcn_global_load_lds((const unsigned*)(Vb + (size_t)(t) * 64 * LDK + voff[i]), (LAS unsigned*)(lds + (b) * BUF + KBYTES + (wave * 2 + i) * 1024), 16, 0, 0); } while (0)
    asm volatile("s_waitcnt vmcnt(0)" ::: "memory");
#pragma unroll
    for (int ks = 0; ks < 16; ++ks) asm volatile("" : "+v"(Qf[ks]));
    __builtin_amdgcn_s_barrier();
    asm volatile("" ::: "memory");
    CX_ISSUE(0, 0); CX_ISSUE(1, 1);
    const int q4 = (lane & 15) >> 2, p4 = lane & 3, g16 = (lane >> 4) & 1;
    const int yy = (h ^ l31) << 4;
    const int kp_off = l31 * 512;
    const int vp_off = KBYTES + (4 * h + q4) * 256 + g16 * 32 + p4 * 8;
    const int q64 = q4 * 64;
#pragma unroll 1
    for (int t = 0; t < 4; ++t) {
        if (t < 3) asm volatile("s_waitcnt vmcnt(6)" ::: "memory"); else asm volatile("s_waitcnt vmcnt(0)" ::: "memory");
        __builtin_amdgcn_s_barrier();
        asm volatile("" ::: "memory");
        const LAS unsigned char* kp = lds + (t & 1) * BUF + kp_off;
        const LAS unsigned char* vp = lds + (t & 1) * BUF + vp_off;
        f32x16 s0, s1;
#pragma unroll
        for (int r = 0; r < 16; ++r) { s0[r] = 0.f; s1[r] = 0.f; }
#pragma unroll
        for (int ks = 0; ks < 16; ++ks) {
            const bf16x8 a0 = *(const LAS bf16x8*)(kp + ((ks * 32) ^ yy));
            const bf16x8 a1 = *(const LAS bf16x8*)(kp + 32 * 512 + ((ks * 32) ^ yy));
            const bf16x8 qf = Qf[ks];
            s0 = MFMA32(a0, qf, s0); s1 = MFMA32(a1, qf, s1);
        }
        float mx = fmaxf(s0[0], s1[0]);
#pragma unroll
        for (int r = 1; r < 16; ++r) mx = fmaxf(mx, fmaxf(s0[r], s1[r]));
        mx *= csc;
        mx = fmaxf(mx, __shfl_xor(mx, 32));
        if (__any(mx > mused + 8.f)) {
            const float mn = fmaxf(mused, mx), alpha = fexp2(mused - mn); mused = mn; lsum *= alpha;
#pragma unroll
            for (int d = 0; d < 4; ++d)
#pragma unroll
                for (int r = 0; r < 16; ++r) O[d][r] *= alpha;
        }
        float rs = 0.f; const float nm = -mused;
#pragma unroll
        for (int r = 0; r < 16; ++r) { s0[r] = fexp2(__builtin_fmaf(s0[r], csc, nm)); s1[r] = fexp2(__builtin_fmaf(s1[r], csc, nm)); rs += s0[r] + s1[r]; }
        lsum += rs;
        bf16x8 pb[4];
#pragma unroll
        for (int sp = 0; sp < 2; ++sp) {
            u32x4 w0, w1;
            w0.x = pk2(s0[8 * sp + 0], s0[8 * sp + 1]); w0.y = pk2(s0[8 * sp + 2], s0[8 * sp + 3]); w0.z = pk2(s0[8 * sp + 4], s0[8 * sp + 5]); w0.w = pk2(s0[8 * sp + 6], s0[8 * sp + 7]);
            w1.x = pk2(s1[8 * sp + 0], s1[8 * sp + 1]); w1.y = pk2(s1[8 * sp + 2], s1[8 * sp + 3]); w1.z = pk2(s1[8 * sp + 4], s1[8 * sp + 5]); w1.w = pk2(s1[8 * sp + 6], s1[8 * sp + 7]);
            pb[sp] = __builtin_bit_cast(bf16x8, w0); pb[2 + sp] = __builtin_bit_cast(bf16x8, w1);
        }
#pragma unroll
        for (int ks = 0; ks < 4; ++ks) {
#pragma unroll
            for (int d = 0; d < 4; ++d) {
                const s16x4 r0 = vtr(vp + (16 * ks) * 256 + ((d * 64) ^ q64));
                const s16x4 r1 = vtr(vp + (16 * ks + 8) * 256 + ((d * 64) ^ q64));
                const bf16x8 vf = {r0[0], r0[1], r0[2], r0[3], r1[0], r1[1], r1[2], r1[3]};
                O[d] = MFMA32(vf, pb[ks], O[d]);
            }
        }
        if (t + 2 < 4) {
            asm volatile("s_waitcnt lgkmcnt(0)" ::: "memory");
            __builtin_amdgcn_s_barrier();
            asm volatile("" ::: "memory");
            CX_ISSUE(t + 2, t & 1);
        }
    }
#undef CX_ISSUE
    lsum += __shfl_xor(lsum, 32);
    const float inv = 1.f / lsum;
#pragma unroll
    for (int d = 0; d < 4; ++d)
#pragma unroll
        for (int r = 0; r < 16; ++r) O[d][r] *= inv;
}


__device__ __forceinline__ void cross_unit(LAS unsigned char* lds, const bf16_t* Qw, const bf16_t* Kb, const bf16_t* Vb, float csc, bf16_t* orow  ) {
    constexpr int LDK = 2048, TB = 32768;
    const int tid = threadIdx.x, lane = tid & 63, l31 = lane & 31, h = lane >> 5, wave = __builtin_amdgcn_readfirstlane(tid >> 6);
    bf16x8 Qf[16];
    const bf16_t* qbase = Qw + (size_t)l31 * DM + h * 8;
#pragma unroll
    for (int ks = 0; ks < 16; ++ks) Qf[ks] = *(const bf16x8*)(qbase + ks * 16);
    unsigned koff[4], voff[4];
#pragma unroll
    for (int i = 0; i < 4; ++i) { const int j = wave * 4 + i, r = 2 * j + (lane >> 5), p = lane & 31; koff[i] = (unsigned)(r * LDK + (p ^ (r & 31)) * 8); voff[i] = (unsigned)(r * LDK + (p ^ ((r & 3) << 2)) * 8); }
    asm volatile("s_waitcnt vmcnt(0)" ::: "memory");
#pragma unroll
    for (int ks = 0; ks < 16; ++ks) asm volatile("" : "+v"(Qf[ks]));
    asm volatile("s_waitcnt lgkmcnt(0)" ::: "memory");
    __builtin_amdgcn_s_barrier();
    asm volatile("" ::: "memory");
#pragma unroll
    for (int t = 0; t < 4; ++t)
#pragma unroll
        for (int i = 0; i < 4; ++i) __builtin_amdgcn_global_load_lds((const unsigned*)(Kb + (size_t)t * 64 * LDK + koff[i]), (LAS unsigned*)(lds + t * TB + (wave * 4 + i) * 1024), 16, 0, 0);
    asm volatile("s_waitcnt vmcnt(0)" ::: "memory");
    __builtin_amdgcn_s_barrier();
    asm volatile("" ::: "memory");
    const int yy = (h ^ l31) << 4;
    f32x16 S[4][2];
#pragma unroll
    for (int t = 0; t < 4; ++t) {
        const LAS unsigned char* kp = lds + t * TB + l31 * 512;
#pragma unroll
        for (int r = 0; r < 16; ++r) { S[t][0][r] = 0.f; S[t][1][r] = 0.f; }
#pragma unroll
        for (int ks = 0; ks < 16; ++ks) {
            const bf16x8 a0 = *(const LAS bf16x8*)(kp + ((ks * 32) ^ yy));
            const bf16x8 a1 = *(const LAS bf16x8*)(kp + 32 * 512 + ((ks * 32) ^ yy));
            S[t][0] = MFMA32(a0, Qf[ks], S[t][0]); S[t][1] = MFMA32(a1, Qf[ks], S[t][1]);
        }
    }
    asm volatile("s_waitcnt lgkmcnt(0)" ::: "memory");
    __builtin_amdgcn_s_barrier();
    asm volatile("" ::: "memory");
#pragma unroll
    for (int t = 0; t < 4; ++t)
#pragma unroll
        for (int i = 0; i < 4; ++i) __builtin_amdgcn_global_load_lds((const unsigned*)(Vb + (size_t)t * 64 * LDK + voff[i]), (LAS unsigned*)(lds + t * TB + (wave * 4 + i) * 1024), 16, 0, 0);
    float mx = fmaxf(S[0][0][0], S[0][1][0]);
#pragma unroll
    for (int t = 0; t < 4; ++t)
#pragma unroll
        for (int r = 0; r < 16; ++r) mx = fmaxf(mx, fmaxf(S[t][0][r], S[t][1][r]));
    mx = fmaxf(mx, __shfl_xor(mx, 32));
    const float nm = -mx * csc;
    float lsum = 0.f;
    bf16x8 pb[4][4];
#pragma unroll
    for (int t = 0; t < 4; ++t) {
#pragma unroll
        for (int r = 0; r < 16; ++r) { S[t][0][r] = fexp2(__builtin_fmaf(S[t][0][r], csc, nm)); S[t][1][r] = fexp2(__builtin_fmaf(S[t][1][r], csc, nm)); lsum += S[t][0][r] + S[t][1][r]; }
#pragma unroll
        for (int sp = 0; sp < 2; ++sp) {
            u32x4 w0, w1;
            w0.x = pk2(S[t][0][8 * sp + 0], S[t][0][8 * sp + 1]); w0.y = pk2(S[t][0][8 * sp + 2], S[t][0][8 * sp + 3]); w0.z = pk2(S[t][0][8 * sp + 4], S[t][0][8 * sp + 5]); w0.w = pk2(S[t][0][8 * sp + 6], S[t][0][8 * sp + 7]);
            w1.x = pk2(S[t][1][8 * sp + 0], S[t][1][8 * sp + 1]); w1.y = pk2(S[t][1][8 * sp + 2], S[t][1][8 * sp + 3]); w1.z = pk2(S[t][1][8 * sp + 4], S[t][1][8 * sp + 5]); w1.w = pk2(S[t][1][8 * sp + 6], S[t][1][8 * sp + 7]);
            pb[t][sp] = __builtin_bit_cast(bf16x8, w0); pb[t][2 + sp] = __builtin_bit_cast(bf16x8, w1);
        }
    }
    lsum += __shfl_xor(lsum, 32);
    const float inv = 1.f / lsum;
    asm volatile("s_waitcnt vmcnt(0)" ::: "memory");
    __builtin_amdgcn_s_barrier();
    asm volatile("" ::: "memory");
    const int q4 = (lane & 15) >> 2, p4 = lane & 3, g16 = (lane >> 4) & 1, q64 = q4 * 64;
    const int vp_off = (4 * h + q4) * 512 + g16 * 32 + p4 * 8;
#pragma unroll 1
    for (int half = 0; half < 2; ++half) {
        f32x16 O[4];
#pragma unroll
        for (int d = 0; d < 4; ++d)
#pragma unroll
            for (int r = 0; r < 16; ++r) O[d][r] = 0.f;
#pragma unroll
        for (int t = 0; t < 4; ++t) {
            const LAS unsigned char* vp = lds + t * TB + vp_off + half * 256;
#pragma unroll
            for (int ks = 0; ks < 4; ++ks) {
#pragma unroll
                for (int d = 0; d < 4; ++d) {
                    const s16x4 r0 = vtr(vp + (16 * ks) * 512 + ((d * 64) ^ q64));
                    const s16x4 r1 = vtr(vp + (16 * ks + 8) * 512 + ((d * 64) ^ q64));
                    const bf16x8 vf = __builtin_shufflevector(r0, r1, 0, 1, 2, 3, 4, 5, 6, 7);
                    O[d] = MFMA32(vf, pb[t][ks], O[d]);
                }
            }
        }
#pragma unroll
        for (int d = 0; d < 4; ++d)
#pragma unroll
            for (int j = 0; j < 4; ++j) { u32x2 w; w.x = pk2(O[d][4 * j] * inv, O[d][4 * j + 1] * inv); w.y = pk2(O[d][4 * j + 2] * inv, O[d][4 * j + 3] * inv);
                *(u32x2*)(orow + half * 128 + 32 * d + 8 * j + 4 * h) = w; }
    }
}

template <int NB> __device__ __forceinline__ void store_ot(const f32x16 (&O)[NB], bf16_t* orow  , int h) {
#pragma unroll
    for (int d = 0; d < NB; ++d)
#pragma unroll
        for (int j = 0; j < 4; ++j) { u32x2 w; w.x = pk2(O[d][4 * j], O[d][4 * j + 1]); w.y = pk2(O[d][4 * j + 2], O[d][4 * j + 3]);
            *(u32x2*)(orow + 32 * d + 8 * j + 4 * h) = w; }
}
}


#define XB_TMO      128
#define XB_XCNT(j)  (256  + 64 * (j))
#define XB_XSUB(j)  (1280 + 64 * (j))
#define XB_XGEN(j)  (2304 + 64 * (j))
#define XB_TOP      3328
#define XB_TOPGEN   3392
#define XCD_BAR_WORDS 3456
#define XB_SPIN_CAP (1u << 22)
__device__ __forceinline__ unsigned xb_ld(unsigned* p)              { return __hip_atomic_load(p, __ATOMIC_RELAXED, __HIP_MEMORY_SCOPE_AGENT); }
__device__ __forceinline__ unsigned xb_add(unsigned* p, unsigned v) { return __hip_atomic_fetch_add(p, v, __ATOMIC_RELAXED, __HIP_MEMORY_SCOPE_AGENT); }
__device__ __forceinline__ unsigned xb_xcc_id() { return (unsigned)__builtin_amdgcn_s_getreg((3 << 11) | 20) & 0xFu; }
#define XB_SPIN(cond, bar) do { unsigned _sp = 0; while (cond) { __builtin_amdgcn_s_sleep(1); \
    if ((++_sp & 255u) == 0u) { if (xb_ld(&(bar)[XB_TMO])) break; if (_sp > XB_SPIN_CAP) { atomicAdd(&(bar)[XB_TMO], 1u); break; } } } } while (0)
struct XcdBarrier { unsigned* bar; unsigned x; volatile LAS unsigned* st; };
__device__ __forceinline__ XcdBarrier xcd_barrier_post(unsigned* bar, volatile LAS unsigned* st) {
    XcdBarrier b; b.bar = bar; b.x = xb_xcc_id(); b.st = st;
    if (threadIdx.x == 0) (void)xb_add(&bar[XB_XCNT(b.x)], 1u);
    return b;
}
__device__ __forceinline__ void xcd_barrier_complete(unsigned* bar, unsigned x, unsigned& nloc, unsigned& nx) {
    const unsigned G = gridDim.x * gridDim.y * gridDim.z;
    unsigned sum, cnt, mine, sp = 0u;
    for (;;) {
        sum = 0u; cnt = 0u; mine = 0u;
#pragma unroll
        for (unsigned j = 0; j < 16; ++j) { const unsigned c = xb_ld(&bar[XB_XCNT(j)]); sum += c; cnt += (c > 0u) ? 1u : 0u; mine = (j == x) ? c : mine; }
        if (sum == G) break;
        __builtin_amdgcn_s_sleep(1);
        if ((++sp & 255u) == 0u) { if (xb_ld(&bar[XB_TMO])) break; if (sp > XB_SPIN_CAP) { atomicAdd(&bar[XB_TMO], 1u); break; } }
    }
    nloc = mine > 0u ? mine : 1u; nx = cnt > 0u ? cnt : 1u;
}
__device__ __forceinline__ void xcd_barrier(const XcdBarrier& b) {
    asm volatile("s_waitcnt vmcnt(0)" ::: "memory");
    __syncthreads();
    if (threadIdx.x == 0) {
        unsigned* bar = b.bar;
        __builtin_amdgcn_s_waitcnt(0);
        unsigned nloc = b.st[0], nx = b.st[1];
        if (nloc == 0u) { xcd_barrier_complete(bar, b.x, nloc, nx); b.st[0] = nloc; b.st[1] = nx; }
        const unsigned old = xb_add(&bar[XB_XSUB(b.x)], 1u);
        const unsigned gen = old / nloc;
        if (old + 1u == (gen + 1u) * nloc) {
            __builtin_amdgcn_fence(__ATOMIC_RELEASE, "agent");
            asm volatile("s_waitcnt vmcnt(0)" ::: "memory");
            const unsigned og = xb_add(&bar[XB_TOP], 1u);
            const unsigned tg = og / nx;
            if (og + 1u == (tg + 1u) * nx) xb_add(&bar[XB_TOPGEN], 1u);
            else XB_SPIN(xb_ld(&bar[XB_TOPGEN]) == tg, bar);
            __builtin_amdgcn_fence(__ATOMIC_ACQUIRE, "agent");
            xb_add(&bar[XB_XGEN(b.x)], 1u);
            asm volatile("s_waitcnt vmcnt(0)" ::: "memory");
        } else {
            XB_SPIN(xb_ld(&bar[XB_XGEN(b.x)]) == gen, bar);
            __builtin_amdgcn_fence(__ATOMIC_ACQUIRE, "agent");
            asm volatile("s_waitcnt vmcnt(0)" ::: "memory");
        }
    }
    __syncthreads();
}

struct Args { const float* in[22]; float* out; unsigned char* ws; int ph_lo, ph_hi; };
constexpr int NWAVES = 8, LDS_BYTES = 147456, NPHASE = 11;

__device__ __forceinline__ void transpose_item(const float* W, int N, bf16_t* WT, int ldt, int k_off, LAS float* scr, int kb, int nb, int lane, const float* gain, int mapmode) {
    const int k0 = 64 * kb, n0 = 32 * nb;
    const int nn = n0 + (lane & 31);
    int src = nn;
    if (mapmode == 1) { if (nn < 1024) src = (nn & ~63) + ((nn & 63) >> 1) + 32 * (nn & 1); }
    else if (mapmode == 2) { src = (nn & 1) ? (DFF + (nn >> 1)) : (nn >> 1); }
    float wv[32];
#pragma unroll
    for (int i = 0; i < 32; ++i) { const int kk = 2 * i + (lane >> 5); wv[i] = __builtin_nontemporal_load(W + (size_t)(k0 + kk) * N + src); }
    if (gain) {
#pragma unroll
        for (int i = 0; i < 32; ++i) wv[i] *= gain[k0 + 2 * i + (lane >> 5)];
    }
#pragma unroll
    for (int i = 0; i < 32; ++i) { const int kk = 2 * i + (lane >> 5); scr[kk * 33 + (lane & 31)] = wv[i]; }
    asm volatile("s_waitcnt lgkmcnt(0)" ::: "memory");
    const int c = lane & 7;
#pragma unroll
    for (int j = 0; j < 4; ++j) { const int n = (lane >> 3) + 8 * j; const LAS float* s = scr + (8 * c) * 33 + n;
        u32x4 o; o.x = pk2(s[0 * 33], s[1 * 33]); o.y = pk2(s[2 * 33], s[3 * 33]); o.z = pk2(s[4 * 33], s[5 * 33]); o.w = pk2(s[6 * 33], s[7 * 33]);
        *(u32x4*)(WT + (size_t)(n0 + n) * ldt + k_off + k0 + 8 * c) = o; }
    asm volatile("s_waitcnt lgkmcnt(0)" ::: "memory");
}

__device__ __forceinline__ void row_to_bf16(const float* xrow, bf16_t* orow, float* rstd_out, int lane) {
    const f32x4* xr = (const f32x4*)xrow + lane;
    f32x4 v[4]; float s = 0.f;
#pragma unroll
    for (int j = 0; j < 4; ++j) { v[j] = xr[64 * j]; s += (v[j].x * v[j].x + v[j].y * v[j].y) + (v[j].z * v[j].z + v[j].w * v[j].w); }
    s = wave_sum(s);
    if (lane == 0) *rstd_out = 1.f / sqrtf(s * (1.f / DM) + EPS);
    u32x2* o8 = (u32x2*)orow + lane;
#pragma unroll
    for (int j = 0; j < 4; ++j) { u32x2 w; w.x = pk2(v[j].x, v[j].y); w.y = pk2(v[j].z, v[j].w); o8[64 * j] = w; }
}

__device__ __forceinline__ void row2_to_bf16(const float* xrow, bf16_t* orow, float* rstd_out, int lane, size_t rstride, int sstride, bool two) {
    const f32x4* xr = (const f32x4*)xrow + lane; const f32x4* xr2 = (const f32x4*)(xrow + (two ? rstride : 0)) + lane;
    f32x4 v[4], w[4]; float s = 0.f, s2 = 0.f;
#pragma unroll
    for (int j = 0; j < 4; ++j) { v[j] = xr[64 * j]; w[j] = xr2[64 * j]; }
#pragma unroll
    for (int j = 0; j < 4; ++j) { s += (v[j].x * v[j].x + v[j].y * v[j].y) + (v[j].z * v[j].z + v[j].w * v[j].w); s2 += (w[j].x * w[j].x + w[j].y * w[j].y) + (w[j].z * w[j].z + w[j].w * w[j].w); }
    s = wave_sum(s); s2 = wave_sum(s2);
    if (lane == 0) { rstd_out[0] = 1.f / sqrtf(s * (1.f / DM) + EPS); if (two) rstd_out[sstride] = 1.f / sqrtf(s2 * (1.f / DM) + EPS); }
    u32x2* o8 = (u32x2*)orow + lane;
#pragma unroll
    for (int j = 0; j < 4; ++j) { u32x2 p; p.x = pk2(v[j].x, v[j].y); p.y = pk2(v[j].z, v[j].w); o8[64 * j] = p; }
    if (two) { u32x2* o9 = (u32x2*)(orow + rstride) + lane;
#pragma unroll
        for (int j = 0; j < 4; ++j) { u32x2 p; p.x = pk2(w[j].x, w[j].y); p.y = pk2(w[j].z, w[j].w); o9[64 * j] = p; } }
}

__device__ __forceinline__ void row4_to_bf16(const float* xrow, bf16_t* orow, float* rstd_out, int lane, size_t rstride, int sstride) {
    f32x4 v[4][4]; float s[4];
#pragma unroll
    for (int q = 0; q < 4; ++q)
#pragma unroll
        for (int j = 0; j < 4; ++j) v[q][j] = __builtin_nontemporal_load((const f32x4*)(xrow + q * rstride) + lane + 64 * j);
#pragma unroll
    for (int q = 0; q < 4; ++q) { s[q] = 0.f;
#pragma unroll
        for (int j = 0; j < 4; ++j) s[q] += (v[q][j].x * v[q][j].x + v[q][j].y * v[q][j].y) + (v[q][j].z * v[q][j].z + v[q][j].w * v[q][j].w); }
#pragma unroll
    for (int o = 1; o < 64; o <<= 1) {
#pragma unroll
        for (int q = 0; q < 4; ++q) s[q] += __shfl_xor(s[q], o); }
    if (lane == 0) {
#pragma unroll
        for (int q = 0; q < 4; ++q) rstd_out[q * sstride] = 1.f / sqrtf(s[q] * (1.f / DM) + EPS); }
#pragma unroll
    for (int q = 0; q < 4; ++q) { u32x2* o8 = (u32x2*)(orow + q * rstride) + lane;
#pragma unroll
        for (int j = 0; j < 4; ++j) { u32x2 p; p.x = pk2(v[q][j].x, v[q][j].y); p.y = pk2(v[q][j].z, v[q][j].w); o8[64 * j] = p; } }
}

__device__ __forceinline__ double sin_poly(double r) {
    const double r2 = r * r; double t = 1.0, s = 1.0;
#pragma unroll
    for (int k = 1; k <= 14; ++k) { t *= -r2 / (double)((2 * k) * (2 * k + 1)); s += t; }
    return r * s;
}
__device__ __forceinline__ double cos_poly(double r) {
    const double r2 = r * r; double t = 1.0, s = 1.0;
#pragma unroll
    for (int k = 1; k <= 15; ++k) { t *= -r2 / (double)((2 * k - 1) * (2 * k)); s += t; }
    return s;
}

__global__ void __launch_bounds__(NWAVES * 64, 2) mk_fwd(Args args) {
    extern __shared__ __attribute__((aligned(16))) unsigned char lds_raw[];
    LAS unsigned char* lds = (LAS unsigned char*)lds_raw;
    const int tid = threadIdx.x, lane = tid & 63, wave = __builtin_amdgcn_readfirstlane(tid >> 6);
    const int G = gridDim.x, bx = blockIdx.x;
    unsigned char* ws = args.ws;
    float* stats = (float*)(ws + WS_STATS);
    const float* x = args.in[0]; const float* mem = args.in[1];
    bf16_t* WinT = (bf16_t*)(ws + WS_WIN); bf16_t* WupT = (bf16_t*)(ws + WS_WUP); bf16_t* WoutT = (bf16_t*)(ws + WS_WOUT); bf16_t* WcqT = (bf16_t*)(ws + WS_WCQ);
    bf16_t* WckvT = (bf16_t*)(ws + WS_WCKV); bf16_t* WcoT = (bf16_t*)(ws + WS_WCO); bf16_t* WguT = (bf16_t*)(ws + WS_WGU); bf16_t* WdT = (bf16_t*)(ws + WS_WD);
    bf16_t* KVX = (bf16_t*)(ws + WS_KVX); bf16_t* MEMB = (bf16_t*)(ws + WS_MEMB); bf16_t* XB = (bf16_t*)(ws + WS_XB); bf16_t* Y = XB;
    bf16_t* QKV = (bf16_t*)(ws + WS_QKV); bf16_t* T = (bf16_t*)(ws + WS_T); bf16_t* QX = (bf16_t*)(ws + WS_QX); bf16_t* OX = (bf16_t*)(ws + WS_OX);
    bf16_t* ACT = (bf16_t*)(ws + WS_ACT); bf16_t* GB = (bf16_t*)(ws + WS_G); bf16_t* X1B = (bf16_t*)(ws + WS_X1B); bf16_t* X2B = (bf16_t*)(ws + WS_X2B);
    float* out = args.out;
    const int lo = args.ph_lo, hi = args.ph_hi;
#ifndef PH_MASK
#define PH_MASK 0x7ff
#endif
#define IN(k) (((PH_MASK >> (k)) & 1) && lo <= (k) && (k) < hi)
#if ONE_LAUNCH
    volatile LAS unsigned* bst = (volatile LAS unsigned*)(lds + LDS_BYTES - 64);
    if (tid < 2) bst[tid] = 0u;
    __syncthreads();
    const XcdBarrier xbar = xcd_barrier_post((unsigned*)(ws + WS_CTL), bst);
#define SEAM(k) do { if (IN(k) && IN((k) + 1)) xcd_barrier(xbar); } while (0)
    if (args.ph_lo < 0) cg::this_grid().sync();
#else
#define SEAM(k) do { } while (0)
#endif

    if (IN(0)) for (int prb = 0; prb < REP_P0; ++prb) {
        LAS float* scr = (LAS float*)(lds + wave * 16384);
        const int gw = bx * NWAVES + wave, NGW = G * NWAVES;
        constexpr int I_IN = 16 * 160, I_UP = 8 * 32, I_SQ = 16 * 32, I_CKV = 16 * 64, I_GU = 16 * 176, I_D = 44 * 32;
        constexpr int NITEMS = I_IN + 2 * I_UP + 3 * I_SQ + I_CKV + I_GU + I_D;
        for (int it = gw; it < NITEMS; it += NGW) {
            int r = it;
            if (r < I_IN) { transpose_item(args.in[3], INC, WinT, DM, 0, scr, r / 160, r % 160, lane, args.in[2], 1); continue; } r -= I_IN;
            if (r < I_UP) { transpose_item(args.in[10], DM, WupT, DM, 0, scr, r / 32, r % 32, lane, nullptr, 0); continue; } r -= I_UP;
            if (r < I_UP) { transpose_item(args.in[11], DM, WupT, DM, 512, scr, r / 32, r % 32, lane, nullptr, 0); continue; } r -= I_UP;
            if (r < I_SQ) { transpose_item(args.in[12], DM, WoutT, DM, 0, scr, r / 32, r % 32, lane, nullptr, 0); continue; } r -= I_SQ;
            if (r < I_SQ) {
#pragma unroll
                for (int q = 0; q < 2; ++q) { const int k = 2 * r + q; const float gk = args.in[13][k]; const f32x4* wr_ = (const f32x4*)(args.in[15] + (size_t)k * DM) + lane; u32x2* o8 = (u32x2*)(WcqT + (size_t)k * DM) + lane;
#pragma unroll
                    for (int j = 0; j < 4; ++j) { const f32x4 v = wr_[64 * j] * gk; u32x2 w; w.x = pk2(v.x, v.y); w.y = pk2(v.z, v.w); o8[64 * j] = w; } }
                continue; } r -= I_SQ;
            if (r < I_SQ) { transpose_item(args.in[17], DM, WcoT, DM, 0, scr, r / 32, r % 32, lane, nullptr, 0); continue; } r -= I_SQ;
            if (r < I_CKV) { transpose_item(args.in[16], 2 * DM, WckvT, DM, 0, scr, r / 64, r % 64, lane, args.in[14], 0); continue; } r -= I_CKV;
            if (r < I_GU) { transpose_item(args.in[19], 2 * DFF, WguT, DM, 0, scr, r / 176, r % 176, lane, args.in[18], 2); continue; } r -= I_GU;
            transpose_item(args.in[20], DM, WdT, DFF, 0, scr, r / 32, r % 32, lane, nullptr, 0);
        }
        for (int m = gw; m < MROWS; m += 4 * NGW) {
            if (m + 3 * NGW < MROWS) row4_to_bf16(x + (size_t)m * DM, XB + (size_t)m * DM, stats + ST_RSTD1 + m, lane, (size_t)NGW * DM, NGW);
            else for (int mm = m; mm < MROWS; mm += NGW) row_to_bf16(x + (size_t)mm * DM, XB + (size_t)mm * DM, stats + ST_RSTD1 + mm, lane);
        }
        for (int m = gw; m < MEMROWS; m += NGW) row_to_bf16(mem + (size_t)m * DM, MEMB + (size_t)m * DM, stats + ST_RSTDM + m, lane);
        const int gt = bx * (NWAVES * 64) + tid, NGT = G * NWAVES * 64;
        for (int i = gt; i < 3 * MROWS; i += NGT) stats[ST_SSQ2 + i] = 0.f;
        for (int i = gt; i < SEQ * 32; i += NGT) {
            const int pos = i >> 5, fi = i & 31;
            const float inv = (float)exp2(-(double)fi * (13.287712379549449 / 32.0));
            const float ang = (float)pos * inv;
            const double a = (double)ang; const double k = rint(a * 0.15915494309189535); const double rr = fma(-k, 6.283185307179586, a) - k * 2.4492935982947064e-16;
            stats[ST_COS + i] = (float)cos_poly(rr); stats[ST_SIN + i] = (float)sin_poly(rr);
        }
        if (gt < 64) {
            const float a = wave_sum(args.in[4][lane] * args.in[5][lane]), b = wave_sum(args.in[6][lane] * args.in[7][lane]);
            if (gt == 0) stats[ST_LAM] = expf(a) - expf(b) + 0.2f;
        }
    }
    SEAM(0);

    if (IN(1)) for (int prb = 0; prb < REP_P1; ++prb) {
        { pg8::Gemm g{XB, WinT + (size_t)QKVW * DM, DM, DM, DM}; pg8::StaticOrder S; S.init(MROWS, GW, G, bx);
          pg8::EpiZ E{QKV, GB, stats + ST_RSTD1, stats + ST_COS, stats + ST_SIN, 12};
          pg8::gemm_phase(lds, g, S, E); }
        { pg8::Gemm g{XB, WinT, DM, DM, DM}; pg8::StaticOrder S; S.init(MROWS, QKVW, G, bx);
          pg8::EpiZ E{QKV, GB, stats + ST_RSTD1, stats + ST_COS, stats + ST_SIN, 0};
          pg8::gemm_phase(lds, g, S, E); }
        { pg8::Gemm g{MEMB, WckvT, DM, DM, DM}; pg8::StaticOrder S; S.init(2 * MEMROWS, 2 * DM, G, bx);
          pg8::EpiScaleHalf E{KVX, 2 * DM, stats + ST_RSTDM};
          pg8::gemm_phase<pg8::EpiScaleHalf, false, true, pg8::StaticOrder, true>(lds, g, S, E); }
    }
    SEAM(1);

#ifndef REP_P2
#define REP_P2 1
#endif
#ifndef REP_P6
#define REP_P6 1
#endif
    if (IN(2)) for (int prb = 0; prb < REP_P2; ++prb) {
        const float lam = stats[ST_LAM];
        const float* subln = args.in[8]; const float* relb = args.in[9];
        const int l31 = lane & 31, h = lane >> 5;
#ifndef NO_A
        for (int i0 = bx; i0 < 256; i0 += G) {
#pragma unroll 1
            for (int rep = 0; rep < 2; ++rep) {
                const int i = rep ? 511 - i0 : i0;
                const int qb = 7 - (i >> 6), bh = i & 63, b = bh >> 2, hd = bh & 3;
                const int q0 = qb * 256 + wave * 32, cw = 4 * qb + (wave >> 1);
                const size_t rowb = (size_t)b * SEQ;
                f32x16 O1[4], O2[4];
                bf16_t* yrow = Y + (rowb + q0 + l31) * DM + hd * 128;
                fa::flash_pass_dma<128, 0>(lds, QKV + (rowb + q0) * QKVW + hd * 128, QKVW, QKV + rowb * QKVW + 512 + hd * 128, QKVW, QKV + rowb * QKVW + 1024 + hd * 128, QKVW,
                                           0, 4 * qb + 4, 0, cw + 1, 0.125f * LOG2E, 0, O1);
                fa::store_ot<4>(O1, yrow, h);
                fa::flash_pass_dma<128, 0>(lds, QKV + (rowb + q0) * QKVW + hd * 128 + 64, QKVW, QKV + rowb * QKVW + 512 + hd * 128 + 64, QKVW, QKV + rowb * QKVW + 1024 + hd * 128, QKVW,
                                           0, 4 * qb + 4, 0, cw + 1, 0.125f * LOG2E, 0, O2);
                float ss = 0.f;
#pragma unroll
                for (int d = 0; d < 4; ++d)
#pragma unroll
                    for (int j = 0; j < 4; ++j) { const u32x2 w = *(const u32x2*)(yrow + 32 * d + 8 * j + 4 * h);
                        O1[d][4 * j] = bflo(w.x) - lam * O2[d][4 * j]; O1[d][4 * j + 1] = bfhi(w.x) - lam * O2[d][4 * j + 1];
                        O1[d][4 * j + 2] = bflo(w.y) - lam * O2[d][4 * j + 2]; O1[d][4 * j + 3] = bfhi(w.y) - lam * O2[d][4 * j + 3];
#pragma unroll
                        for (int e = 0; e < 4; ++e) ss += O1[d][4 * j + e] * O1[d][4 * j + e]; }
                ss += __shfl_xor(ss, 32);
                const float rn = __builtin_amdgcn_rsqf(ss * (1.f / 128.f) + EPS) * 0.8f;
#pragma unroll
                for (int d = 0; d < 4; ++d)
#pragma unroll
                    for (int j = 0; j < 4; ++j) { const f32x4 gsub = *(const f32x4*)(subln + 32 * d + 8 * j + 4 * h);
#pragma unroll
                        for (int e = 0; e < 4; ++e) O1[d][4 * j + e] *= rn * gsub[e]; }
                fa::store_ot<4>(O1, yrow, h);
            }
        }
#endif
#ifndef NO_B
        for (int j = bx; j < 1024; j += G) {
            const int qb = j >> 7, bh = j & 127, b = bh >> 3, hd = bh & 7;
            const int c0 = 4 * qb, cw = c0 + (wave >> 1), q0 = qb * 256 + wave * 32;
            const size_t rowb = (size_t)b * SEQ;
            __syncthreads();
            { LAS float* bl = (LAS float*)(lds + fa::BIAS_OFF);
              for (int i = tid; i < 4 * fa::BIAS_COPY_N; i += NWAVES * 64) { const int k = i / fa::BIAS_COPY_N, jj = i - k * fa::BIAS_COPY_N; const int v = jj + k;
                  bl[i] = relb[hd * 513 + min(max(575 - v, -256), 256) + 256] * LOG2E; } }
            f32x16 O[2];
            fa::flash_pass_dma<64, 1>(lds, QKV + (rowb + q0) * QKVW + 1536 + hd * 64, QKVW, QKV + rowb * QKVW + 2048 + hd * 64, QKVW, QKV + rowb * QKVW + 2560 + hd * 64, QKVW,
                                      max(0, c0 - 8), c0 + 4, max(0, cw - 8), cw + 1, 0.125f * LOG2E, q0, O);
            fa::store_ot<2>(O, Y + (rowb + q0 + l31) * DM + 512 + hd * 64, h);
        }
#endif
    }
    SEAM(2);

    if (IN(3)) {
        pg8::Gemm g{Y, WupT, DM, DM, 512}; pg8::StaticOrder S; S.init(MROWS, DM, G, bx); pg8::EpiGateMerged E{T, GB};
        pg8::gemm_phase<pg8::EpiGateMerged, true>(lds, g, S, E);
    }
#ifndef NO_PRE
    if (IN(3)) {
        bf16_t* WKt = (bf16_t*)(ws + WS_OX); bf16_t* VWt = WKt + (size_t)16 * 1024 * 1024;
        int kpre = 256; asm volatile("" : "+s"(kpre));
        { pg8::Gemm g{KVX, WcqT, 2 * DM, DM, kpre}; pg8::PreOrder<0> S{G, bx, KVX, WcqT};
          pg8::EpiScale<false> E{WKt, DM, nullptr, 0.0625f * LOG2E}; pg8::gemm_phase<pg8::EpiScale<false>, false, true, pg8::PreOrder<0>>(lds, g, S, E); }
        { pg8::Gemm g{WcoT, KVX, DM, 2 * DM, kpre}; pg8::PreOrder<1> S{G, bx, KVX, WcoT};
          pg8::EpiScale<false> E{VWt, DM, nullptr, 1.f}; pg8::gemm_phase<pg8::EpiScale<false>, false, true, pg8::PreOrder<1>>(lds, g, S, E); }
    }
#endif
    SEAM(3);

    if (IN(4)) {
        pg8::Gemm g{T, WoutT, DM, DM, DM}; pg8::StaticOrder S; S.init(MROWS, DM, G, bx);
        pg8::EpiResid<true> E{x, nullptr, X1B, stats + ST_SSQ2}; pg8::gemm_phase(lds, g, S, E);
    }
    SEAM(4);

    if (IN(5)) {
        const bf16_t* WKt = (const bf16_t*)(ws + WS_OX);
        pg8::Gemm g{X1B, WKt, DM, DM, DM, (size_t)1024 * 1024 * 2}; pg8::StaticOrder S; S.init(MROWS, DM, G, bx);
        pg8::EpiSoftmax E{QX, stats + ST_SSQ2, (LAS float*)(lds + 131072)}; pg8::gemm_phase(lds, g, S, E);
    }
    SEAM(6);

    if (IN(7)) {
        const bf16_t* VWt = (const bf16_t*)(ws + WS_OX) + (size_t)16 * 1024 * 1024;
        pg8::Gemm g{QX, VWt, DM, DM, DM, (size_t)1024 * 1024 * 2}; pg8::StaticOrder S; S.init(MROWS, DM, G, bx);
        pg8::EpiResid<false> E{nullptr, X1B, X2B, stats + ST_SSQ3}; pg8::gemm_phase(lds, g, S, E);
    }
    SEAM(7);

    if (IN(8)) for (int prb = 0; prb < REP_P8; ++prb) {
        pg8::Gemm g{X2B, WguT, DM, DM, DM}; pg8::StaticOrder S; S.init(MROWS, 2 * DFF, G, bx);
        pg8::EpiSwiGLU E{ACT, stats + ST_SSQ3}; pg8::gemm_phase(lds, g, S, E);
    }
    SEAM(8);

    if (IN(9)) {
        pg8::Gemm g{ACT, WdT, DFF, DFF, DFF}; pg8::StaticOrder S; S.init(MROWS, DM, G, bx);
        pg8::EpiResid<false> E{nullptr, X2B, X1B  , stats + ST_SSQ4}; pg8::gemm_phase(lds, g, S, E);
    }
    SEAM(9);

    if (IN(10)) {
        const float* gf = args.in[21];
        const int gw = bx * NWAVES + wave, NGW = G * NWAVES;
        for (int m0 = gw; m0 < MROWS; m0 += 4 * NGW) {
            u32x2 w[4][4]; float rs[4];
#pragma unroll
            for (int q = 0; q < 4; ++q) { const int m = min(m0 + q * NGW, MROWS - 1); rs[q] = stats[ST_SSQ4 + m];
#pragma unroll
                for (int j = 0; j < 4; ++j) w[q][j] = __builtin_nontemporal_load((const u32x2*)(X1B + (size_t)m * DM) + lane + 64 * j); }
#pragma unroll
            for (int q = 0; q < 4; ++q) { const int m = m0 + q * NGW; if (m < MROWS) { const float r = __builtin_amdgcn_rsqf(rs[q] * (1.f / DM) + EPS);
                f32x4* xr = (f32x4*)(out + (size_t)m * DM) + lane;
#pragma unroll
                for (int j = 0; j < 4; ++j) { const f32x4 gg = *((const f32x4*)gf + lane + 64 * j);
                    __builtin_nontemporal_store((f32x4){bflo(w[q][j].x), bfhi(w[q][j].x), bflo(w[q][j].y), bfhi(w[q][j].y)} * r * gg, &xr[64 * j]); } } }
        }
    }
#undef IN
#undef SEAM
}

extern "C" void kernel_launch(void* const* d_in, const int* in_sizes, int n_in, void* d_out, int out_size, void* d_ws, size_t ws_size, hipStream_t stream) {
    static int grid = 0;
    if (grid == 0) {
        if (n_in != 22 || out_size != MROWS * DM || ws_size < WS_END) { fprintf(stderr, "kernel_launch: unexpected shapes (n_in %d out %d ws %zu)\n", n_in, out_size, ws_size); grid = -1; return; }
        int dev = 0, cus = 0, per_cu = 0;
        hipGetDevice(&dev); hipDeviceGetAttribute(&cus, hipDeviceAttributeMultiprocessorCount, dev);
        if (hipFuncSetAttribute((const void*)mk_fwd, hipFuncAttributeMaxDynamicSharedMemorySize, LDS_BYTES) != hipSuccess) { fprintf(stderr, "kernel_launch: hipFuncSetAttribute failed\n"); grid = -1; return; }
        if (hipOccupancyMaxActiveBlocksPerMultiprocessor(&per_cu, (const void*)mk_fwd, NWAVES * 64, LDS_BYTES) != hipSuccess || per_cu < 1) { per_cu = 1; (void)hipGetLastError(); }
        grid = cus * 1;
        fprintf(stderr, "kernel_launch: grid %d (occupancy query %d per CU)\n", grid, per_cu);
    }
    if (grid < 0) return;
#if ONE_LAUNCH
    if (hipMemsetAsync((char*)d_ws + WS_CTL, 0, XCD_BAR_WORDS * 4, stream) != hipSuccess) { fprintf(stderr, "kernel_launch: memset failed\n"); return; }
#endif
    Args a{};
    for (int i = 0; i < 22; ++i) a.in[i] = (const float*)d_in[i];
    a.out = (float*)d_out; a.ws = (unsigned char*)d_ws;
#if ONE_LAUNCH
    a.ph_lo = 0; a.ph_hi = NPHASE;
    void* kargs[] = {&a};
    hipError_t e = hipLaunchCooperativeKernel((const void*)mk_fwd, dim3(grid), dim3(NWAVES * 64), kargs, LDS_BYTES, stream);
    if (e != hipSuccess) fprintf(stderr, "cooperative launch failed: %s (grid %d)\n", hipGetErrorString(e), grid);
#else
#ifndef PROBE_MASK
#define PROBE_MASK 0
#endif
    for (int p = 0; p < NPHASE; ++p) { a.ph_lo = p; a.ph_hi = p + 1; const int nrep = ((PROBE_MASK >> p) & 1) ? 2 : 1;
        for (int r = 0; r < nrep; ++r) hipLaunchKernelGGL(mk_fwd, dim3(grid), dim3(NWAVES * 64), LDS_BYTES, stream, a); }
#endif
}
```

```cpp
#include <hip/hip_runtime.h>
#include <hip/hip_cooperative_groups.h>
#include <cstdio>
#include <cstdint>
namespace cg = cooperative_groups;

#ifndef ONE_LAUNCH
#define ONE_LAUNCH 1
#endif

#define REP_P0 1
#define REP_P1 1
#define REP_P8 1
#define LAS __attribute__((address_space(3)))
typedef unsigned short bf16_t;
typedef short bf16x8 __attribute__((ext_vector_type(8)));
typedef short s16x4 __attribute__((ext_vector_type(4)));
typedef short v4i16_t __attribute__((ext_vector_type(4)));
typedef float f32x4 __attribute__((ext_vector_type(4)));
typedef float f32x16 __attribute__((ext_vector_type(16)));
typedef unsigned u32x4 __attribute__((ext_vector_type(4)));
typedef unsigned u32x2 __attribute__((ext_vector_type(2)));
typedef float f32x2_t __attribute__((ext_vector_type(2)));
typedef __bf16 bf16x2_t __attribute__((ext_vector_type(2)));

constexpr int BATCH = 16, SEQ = 2048, DM = 1024, MROWS = BATCH * SEQ;
constexpr int NMEM = 256, MEMROWS = BATCH * NMEM;
constexpr int INC = 5120, DFF = 2816, QKVW = 3072, GW = 2048;
constexpr float EPS = 1e-6f;
constexpr float LOG2E = 1.4426950408889634f;

constexpr size_t MiB = 1u << 20;
constexpr size_t WS_CTL = 0;
constexpr size_t WS_STATS = 1 * MiB;
constexpr int ST_RSTD1 = 0, ST_SSQ2 = 32768, ST_SSQ3 = 65536, ST_SSQ4 = 98304, ST_RSTDM = 131072, ST_LAM = 135168,
              ST_COS = 147456, ST_SIN = ST_COS + 65536;
constexpr size_t WS_WIN = 4 * MiB, WS_WUP = 14 * MiB, WS_WOUT = 16 * MiB, WS_WCQ = 18 * MiB, WS_WCKV = 20 * MiB, WS_WCO = 24 * MiB,
                 WS_WGU = 26 * MiB, WS_WD = 37 * MiB;
constexpr size_t WS_KVX = 44 * MiB, WS_MEMB = 60 * MiB;
constexpr size_t WS_XB = 68 * MiB;
constexpr size_t WS_QKV = 132 * MiB;
constexpr size_t WS_T = 132 * MiB, WS_QX = 196 * MiB, WS_OX = 260 * MiB, WS_ACT = 132 * MiB;
constexpr size_t WS_G = 324 * MiB;
constexpr size_t WS_X1B = 324 * MiB, WS_X2B = 388 * MiB;
constexpr size_t WS_END = 452 * MiB;

__device__ __forceinline__ unsigned pk2(float lo, float hi) { f32x2_t v = {lo, hi}; bf16x2_t b = __builtin_convertvector(v, bf16x2_t); return __builtin_bit_cast(unsigned, b); }
__device__ __forceinline__ float bf2f(unsigned short h) { return __builtin_bit_cast(float, (unsigned)h << 16); }
__device__ __forceinline__ float bflo(unsigned w) { return __builtin_bit_cast(float, w << 16); }
__device__ __forceinline__ float bfhi(unsigned w) { return __builtin_bit_cast(float, w & 0xffff0000u); }
__device__ __forceinline__ float fexp2(float x) { return __builtin_amdgcn_exp2f(x); }
__device__ __forceinline__ float frcp(float x) { return __builtin_amdgcn_rcpf(x); }
__device__ __forceinline__ float fsigmoid(float x) { return frcp(1.f + fexp2(-x * LOG2E)); }
__device__ __forceinline__ float wave_sum(float v) {
#pragma unroll
    for (int o = 1; o < 64; o <<= 1) v += __shfl_xor(v, o);
    return v;
}

namespace pg8 {
constexpr int BM = 256, BK = 64, HALF = 128, HTB = HALF * BK * 2, NXCD = 8, WGM = 6;
__host__ __device__ __forceinline__ int lds_byte(int r, int c) { const int st = (r >> 4) * 2 + (c >> 5), rr = r & 15, cc = c & 31, ob = rr * 64 + cc * 2; return st * 1024 + (ob ^ (((ob >> 9) & 1) << 5)); }
__host__ __device__ __forceinline__ void stage_rc(int b, int& R, int& C) { const int st = b / 1024, sb = b % 1024, swz = sb ^ (((sb >> 9) & 1) << 5); R = (st >> 1) * 16 + swz / 64; C = (st & 1) * 32 + (swz % 64) / 2; }
__host__ __device__ __forceinline__ int perm32(int rho) { const int n = rho >> 4, i = rho & 15; return 8 * (i >> 2) + 4 * n + (i & 3); }

struct Unit { int pm, pn; };
struct Gemm { const bf16_t* A; const bf16_t* Bt; int lda, ldb, K; size_t bbatch = 0; };

struct StaticOrder {
    int nM, nN, nwg, G, c;
    __device__ void init(int M, int N, int G_, int c_) { nM = M / BM; nN = N / BM; nwg = nM * nN; G = G_; c = c_; }
    __device__ bool next(int i, Unit& u) const {
        const long L = (long)i * G + c; if (L >= nwg) return false;
        int wgid = (int)L; { const int q = nwg / NXCD, r = nwg % NXCD, xcd = wgid % NXCD, off = wgid / NXCD; wgid = (xcd < r ? xcd * (q + 1) : r * (q + 1) + (xcd - r) * q) + off; }
        const int nig = WGM * nN, gid = wgid / nig, fm = gid * WGM, gsz = (nM - fm) < WGM ? (nM - fm) : WGM;
        u.pm = fm + ((wgid % nig) % gsz); u.pn = (wgid % nig) / gsz; return true;
    }
    __device__ __forceinline__ const char* abase(const Gemm& g, const Unit& u, size_t tA) const { return (const char*)g.A + (size_t)u.pm * tA; }
    __device__ __forceinline__ const char* bbase(const Gemm& g, const Unit& u, size_t tB) const { return (const char*)g.Bt + (size_t)u.pn * tB + (size_t)(u.pm >> 3) * g.bbatch; }
};
template <int mode> struct PreOrder {
    int G, c; const bf16_t* kvx; const bf16_t* w;
    __device__ bool next(int i, Unit& u) const { const int L = i * G + c; if (L >= 256) return false; u.pm = L >> 2; u.pn = L & 3; return true; }
    __device__ __forceinline__ const char* abase(const Gemm&, const Unit& u, size_t) const {
        return mode == 0 ? (const char*)(kvx + (size_t)(u.pm >> 2) * 256 * 2048 + (u.pm & 3) * 256) : (const char*)(w + (size_t)(u.pm & 3) * 256 * 1024 + u.pn * 256); }
    __device__ __forceinline__ const char* bbase(const Gemm&, const Unit& u, size_t) const {
        return mode == 0 ? (const char*)(w + (size_t)u.pn * 256 * 1024 + (u.pm & 3) * 256) : (const char*)(kvx + (size_t)(u.pm >> 2) * 256 * 2048 + 1024 + u.pn * 256); }
};

template <class Epi, bool SPLIT2 = false, bool ALIGN_EPI = true, class Sched = StaticOrder, bool HALF_M = false>
__device__ __forceinline__ void gemm_phase(LAS unsigned char* lds, const Gemm g, const Sched& S, const Epi& E) {
    const int tid = threadIdx.x, wid = __builtin_amdgcn_readfirstlane(tid >> 6), lane = tid & 63, wr = wid >> 2, wc = wid & 3, fr = lane & 15, fq = lane >> 4;
    const int K = g.K, nt = K / BK;
    unsigned voffA[2], voffB[2];
#pragma unroll
    for (int i = 0; i < 2; ++i) { int R, C; stage_rc(tid * 16 + i * 8192, R, C); const int Rb = (R & ~31) + perm32(R & 31);
        voffA[i] = (unsigned)(R * g.lda + C) * 2u; voffB[i] = (unsigned)(Rb * g.ldb + C) * 2u; }
    const size_t kstep = (size_t)(BK * 2);
    const size_t hstepA = HALF_M ? 0 : (size_t)HALF * g.lda * 2, hstepB = (size_t)HALF * g.ldb * 2;
    const size_t tstepA = HALF_M ? (size_t)HALF * g.lda * 2 : 2 * hstepA, tstepB = 2 * hstepB;
    const unsigned ldsw = (unsigned)wid * 1024u;
    const int aoff = lds_byte(wr * 64 + fr, fq * 8), boff = lds_byte(wc * 32 + fr, fq * 8);
#define PG8_SA(b, h) (((b) * 2 + (h)) * HTB)
#define PG8_SB(b, h) ((4 + (b) * 2 + (h)) * HTB)
#define PG8_STAGE(bufoff, gbase, voff) do { _Pragma("unroll") for (int _i = 0; _i < 2; ++_i) \
        __builtin_amdgcn_global_load_lds((const unsigned*)((const char*)(gbase) + (voff)[_i]), (LAS unsigned*)(lds + (bufoff) + ldsw + _i * 8192), 16, 0, 0); } while (0)
#define PG8_LDA(dst, b, h) do { _Pragma("unroll") for (int m = 0; m < 4; ++m) _Pragma("unroll") for (int k = 0; k < 2; ++k) dst[m][k] = *(const LAS bf16x8*)(lds + PG8_SA(b, h) + aoff + m * 2048 + k * 1024); } while (0)
#define PG8_LDB(dst, b, h) do { _Pragma("unroll") for (int n = 0; n < 2; ++n) _Pragma("unroll") for (int k = 0; k < 2; ++k) dst[n][k] = *(const LAS bf16x8*)(lds + PG8_SB(b, h) + boff + n * 2048 + k * 1024); } while (0)
#define PG8_MMA(ai, bj, At, Bt) do { __builtin_amdgcn_s_setprio(1); _Pragma("unroll") for (int m = 0; m < 4; ++m) _Pragma("unroll") for (int n = 0; n < 2; ++n) _Pragma("unroll") for (int k = 0; k < 2; ++k) \
        acc[ai][bj][m][n] = __builtin_amdgcn_mfma_f32_16x16x32_bf16(Bt[n][k], At[m][k], acc[ai][bj][m][n], 0, 0, 0); __builtin_amdgcn_s_setprio(0); } while (0)
#define PG8_WAIT_V(n) asm volatile("s_waitcnt vmcnt(" #n ")" ::: "memory")
#define PG8_WAIT_L(n) asm volatile("s_waitcnt lgkmcnt(" #n ")" ::: "memory")
#define PG8_BAR __builtin_amdgcn_s_barrier()
#define PG8_SCHED __builtin_amdgcn_sched_barrier(0)
    Unit cur, nxt; int ui = 0;
    constexpr int SH = SPLIT2 ? 1 : 0; constexpr size_t SUBSTEP = 1024;
    if (!S.next(0, cur)) return;
    f32x4 acc[2][2][4][2];
#pragma unroll
    for (int a = 0; a < 2; ++a)
#pragma unroll
        for (int b = 0; b < 2; ++b)
#pragma unroll
            for (int m = 0; m < 4; ++m)
#pragma unroll
                for (int n = 0; n < 2; ++n) acc[a][b][m][n] = (f32x4){0.f, 0.f, 0.f, 0.f};
    bf16x8 At[4][2], B0[2][2], B1[2][2];
    const char* cA = S.abase(g, cur, tstepA); const char* cB = S.bbase(g, cur, tstepB);
    PG8_STAGE(PG8_SB(0, 0), cB, voffB); PG8_STAGE(PG8_SB(0, 1), cB + hstepB, voffB); PG8_STAGE(PG8_SA(0, 0), cA, voffA); PG8_STAGE(PG8_SA(0, 1), cA + hstepA, voffA);
    if (wr == 1) PG8_BAR;
    PG8_WAIT_V(2); PG8_BAR;
    PG8_STAGE(PG8_SB(1, 0), cB + kstep, voffB); PG8_STAGE(PG8_SA(1, 0), cA + kstep, voffA); PG8_STAGE(PG8_SB(1, 1), cB + hstepB + kstep, voffB);
    PG8_WAIT_V(6); PG8_BAR;
    for (;;) {
        const bool has_next = S.next((ui + 1) >> SH, nxt);
        const size_t nsub = SPLIT2 ? (size_t)((ui + 1) & 1) * SUBSTEP : 0;
        const char* nA = has_next ? S.abase(g, nxt, tstepA) + nsub : cA; const char* nB = has_next ? S.bbase(g, nxt, tstepB) + nsub : cB;
        for (int t = 0; t < nt; t += 2) {
            const bool last = (t == nt - 2);
            const char* a1 = cA + (size_t)(t + 1) * kstep;
            const char* a2 = last ? nA : cA + (size_t)(t + 2) * kstep; const char* b2 = last ? nB : cB + (size_t)(t + 2) * kstep;
            const char* a3 = a2 + kstep; const char* b3 = b2 + kstep;
            PG8_LDB(B0, 0, 0); PG8_LDB(B1, 0, 1); PG8_SCHED; PG8_LDA(At, 0, 0); PG8_STAGE(PG8_SA(1, 1), a1 + hstepA, voffA);
            PG8_WAIT_V(8); PG8_WAIT_L(0); PG8_BAR; PG8_MMA(0, 0, At, B0); PG8_MMA(0, 1, At, B1); PG8_BAR; PG8_SCHED;
            PG8_LDA(At, 0, 1); PG8_STAGE(PG8_SB(0, 0), b2, voffB); PG8_STAGE(PG8_SB(0, 1), b2 + hstepB, voffB); PG8_STAGE(PG8_SA(0, 0), a2, voffA);
            PG8_WAIT_V(8); PG8_WAIT_L(0); PG8_BAR; if constexpr (!HALF_M) { PG8_MMA(1, 0, At, B0); PG8_MMA(1, 1, At, B1); } PG8_BAR; PG8_SCHED;
            PG8_LDB(B0, 1, 0); PG8_LDB(B1, 1, 1); PG8_SCHED; PG8_LDA(At, 1, 0); PG8_STAGE(PG8_SA(0, 1), a2 + hstepA, voffA);
            PG8_WAIT_V(8); PG8_WAIT_L(0); PG8_BAR; PG8_MMA(0, 0, At, B0); PG8_MMA(0, 1, At, B1); PG8_BAR; PG8_SCHED;
            PG8_LDA(At, 1, 1); PG8_STAGE(PG8_SB(1, 0), b3, voffB); PG8_STAGE(PG8_SB(1, 1), b3 + hstepB, voffB); PG8_STAGE(PG8_SA(1, 0), a3, voffA);
            PG8_WAIT_V(8); PG8_WAIT_L(0); PG8_BAR; if constexpr (!HALF_M) { PG8_MMA(1, 0, At, B0); PG8_MMA(1, 1, At, B1); } PG8_BAR; PG8_SCHED;
        }
        if constexpr (ALIGN_EPI) { if (wr == 0) PG8_BAR; }
        if constexpr (SPLIT2) { if (!(ui & 1)) E.first(acc, cur, wr, wc, fr, fq); else E(acc, cur, wr, wc, fr, fq); }
        else E(acc, cur, wr, wc, fr, fq);
        if (!has_next) break;
#pragma unroll
        for (int a = 0; a < 2; ++a)
#pragma unroll
            for (int b = 0; b < 2; ++b)
#pragma unroll
                for (int m = 0; m < 4; ++m)
#pragma unroll
                    for (int n = 0; n < 2; ++n) acc[a][b][m][n] = (f32x4){0.f, 0.f, 0.f, 0.f};
        cur = nxt; cA = nA; cB = nB; ++ui;
        if constexpr (ALIGN_EPI) { if (wr == 1) PG8_BAR; }
    }
    PG8_WAIT_V(0);
    if constexpr (!ALIGN_EPI) { if (wr == 0) PG8_BAR; }
    PG8_BAR;
#undef PG8_SA
#undef PG8_SB
#undef PG8_STAGE
#undef PG8_LDA
#undef PG8_LDB
#undef PG8_MMA
#undef PG8_WAIT_V
#undef PG8_WAIT_L
#undef PG8_BAR
#undef PG8_SCHED
}

#define EPI_LOAD_ROWSCALE(dst, ptr) float dst[2][4]; { const int _r0 = u.pm * BM + wr * 64 + fr; \
    _Pragma("unroll") for (int _a = 0; _a < 2; ++_a) _Pragma("unroll") for (int _m = 0; _m < 4; ++_m) dst[_a][_m] = (ptr)[_r0 + _a * HALF + _m * 16]; \
    asm volatile("s_waitcnt vmcnt(0)" ::: "memory"); \
    _Pragma("unroll") for (int _a = 0; _a < 2; ++_a) _Pragma("unroll") for (int _m = 0; _m < 4; ++_m) asm volatile("" : "+v"(dst[_a][_m])); }
#define EPI_ROWS_BEGIN const int row0 = u.pm * BM + wr * 64 + fr; const int cb = u.pn * BM + wc * 32 + 8 * fq; \
    _Pragma("unroll") for (int ai = 0; ai < 2; ++ai) _Pragma("unroll") for (int m = 0; m < 4; ++m) { const int row = row0 + ai * HALF + m * 16;

__device__ __forceinline__ u32x4 pack8(f32x4 v0, f32x4 v1) { u32x4 w; w.x = pk2(v0[0], v0[1]); w.y = pk2(v0[2], v0[3]); w.z = pk2(v1[0], v1[1]); w.w = pk2(v1[2], v1[3]); return w; }

struct EpiZ {
    bf16_t* QKV; bf16_t* G; const float* rstd; const float* cosT; const float* sinT;
    __device__ __forceinline__ void operator()(const f32x4 (&acc)[2][2][4][2], const Unit& u, int wr, int wc, int fr, int fq) const {
        EPI_LOAD_ROWSCALE(rsv, rstd)
        EPI_ROWS_BEGIN
            const float rs = rsv[ai][m]; const int pos = row & (SEQ - 1);
#pragma unroll
            for (int bj = 0; bj < 2; ++bj) { const int c = cb + bj * HALF; f32x4 v0 = acc[ai][bj][m][0] * rs, v1 = acc[ai][bj][m][1] * rs;
                if (u.pn < 4) {
                    const int i0 = (c & 63) >> 1;
                    const f32x4 cs = *(const f32x4*)(cosT + pos * 32 + i0), sn = *(const f32x4*)(sinT + pos * 32 + i0);
                    f32x4 r0, r1;
                    r0[0] = v0[0] * cs[0] - v0[1] * sn[0]; r0[1] = v0[1] * cs[0] + v0[0] * sn[0];
                    r0[2] = v0[2] * cs[1] - v0[3] * sn[1]; r0[3] = v0[3] * cs[1] + v0[2] * sn[1];
                    r1[0] = v1[0] * cs[2] - v1[1] * sn[2]; r1[1] = v1[1] * cs[2] + v1[0] * sn[2];
                    r1[2] = v1[2] * cs[3] - v1[3] * sn[3]; r1[3] = v1[3] * cs[3] + v1[2] * sn[3];
                    v0 = r0; v1 = r1;
                }
                if (u.pn < 12) { *(u32x4*)(QKV + (size_t)row * QKVW + c) = pack8(v0, v1); }
                else {
#pragma unroll
                    for (int e = 0; e < 4; ++e) { v0[e] = fsigmoid(v0[e]); v1[e] = fsigmoid(v1[e]); }
                    *(u32x4*)(G + (size_t)row * GW + (c - QKVW)) = pack8(v0, v1);
                }
            }
        }
    }
};

template <bool FROM_SSQ> struct EpiScale {
    bf16_t* O; int ldc; const float* rs; float cs = 1.f;
    __device__ __forceinline__ void operator()(const f32x4 (&acc)[2][2][4][2], const Unit& u, int wr, int wc, int fr, int fq) const {
        EPI_ROWS_BEGIN
            float s = cs; if (rs) { s = rs[row]; if (FROM_SSQ) s = __builtin_amdgcn_rsqf(s * (1.f / DM) + EPS); }
#pragma unroll
            for (int bj = 0; bj < 2; ++bj) { const int c = cb + bj * HALF;
                *(u32x4*)(O + (size_t)row * ldc + c) = pack8(acc[ai][bj][m][0] * s, acc[ai][bj][m][1] * s); }
        }
    }
};


struct EpiScaleHalf {
    bf16_t* O; int ldc; const float* rs;
    __device__ __forceinline__ void operator()(const f32x4 (&acc)[2][2][4][2], const Unit& u, int wr, int wc, int fr, int fq) const {
        const int row0 = u.pm * HALF + wr * 64 + fr; const int cb = u.pn * BM + wc * 32 + 8 * fq;
        float sv[4];
#pragma unroll
        for (int m = 0; m < 4; ++m) sv[m] = rs[row0 + m * 16];
        asm volatile("s_waitcnt vmcnt(0)" ::: "memory");
#pragma unroll
        for (int m = 0; m < 4; ++m) asm volatile("" : "+v"(sv[m]));
#pragma unroll
        for (int m = 0; m < 4; ++m) { const int row = row0 + m * 16; const float s = sv[m];
#pragma unroll
            for (int bj = 0; bj < 2; ++bj) { const int c = cb + bj * HALF;
                *(u32x4*)(O + (size_t)row * ldc + c) = pack8(acc[0][bj][m][0] * s, acc[0][bj][m][1] * s); }
        }
    }
};

struct EpiGateMerged {
    bf16_t* T; const bf16_t* G;
    template <bool SECOND> __device__ __forceinline__ void run(const f32x4 (&acc)[2][2][4][2], const Unit& u, int wr, int wc, int fr, int fq) const {
        const int row0 = u.pm * BM + wr * 64 + fr; const int cb = u.pn * BM + wc * 32 + 8 * fq;
#pragma unroll
        for (int ai = 0; ai < 2; ++ai)
#pragma unroll
        for (int mh = 0; mh < 2; ++mh) {
            u32x4 gv[2][2], tv[2][2];
#pragma unroll
            for (int mm = 0; mm < 2; ++mm)
#pragma unroll
                for (int bj = 0; bj < 2; ++bj) { const int row = row0 + ai * HALF + (2 * mh + mm) * 16, c = cb + bj * HALF;
                    gv[mm][bj] = *(const u32x4*)(G + (size_t)row * GW + (SECOND ? DM : 0) + c);
                    if (SECOND) tv[mm][bj] = *(const u32x4*)(T + (size_t)row * DM + c); }
            asm volatile("s_waitcnt vmcnt(0)" ::: "memory");
#pragma unroll
            for (int mm = 0; mm < 2; ++mm)
#pragma unroll
                for (int bj = 0; bj < 2; ++bj) { asm volatile("" : "+v"(gv[mm][bj])); if (SECOND) asm volatile("" : "+v"(tv[mm][bj])); }
#pragma unroll
            for (int mm = 0; mm < 2; ++mm)
#pragma unroll
                for (int bj = 0; bj < 2; ++bj) { const int m = 2 * mh + mm; const int row = row0 + ai * HALF + m * 16, c = cb + bj * HALF;
                    const u32x4 gw = gv[mm][bj];
                    const f32x4 g0 = {bflo(gw.x), bfhi(gw.x), bflo(gw.y), bfhi(gw.y)}, g1 = {bflo(gw.z), bfhi(gw.z), bflo(gw.w), bfhi(gw.w)};
                    f32x4 v0 = acc[ai][bj][m][0] * g0, v1 = acc[ai][bj][m][1] * g1;
                    if (SECOND) { const u32x4 tw = tv[mm][bj];
                        v0 += (f32x4){bflo(tw.x), bfhi(tw.x), bflo(tw.y), bfhi(tw.y)}; v1 += (f32x4){bflo(tw.z), bfhi(tw.z), bflo(tw.w), bfhi(tw.w)}; }
                    *(u32x4*)(T + (size_t)row * DM + c) = pack8(v0, v1); }
        }
    }
    __device__ __forceinline__ void first(const f32x4 (&acc)[2][2][4][2], const Unit& u, int wr, int wc, int fr, int fq) const { run<false>(acc, u, wr, wc, fr, fq); }
    __device__ __forceinline__ void operator()(const f32x4 (&acc)[2][2][4][2], const Unit& u, int wr, int wc, int fr, int fq) const { run<true>(acc, u, wr, wc, fr, fq); }
};

template <bool XIN_F32> struct EpiResid {
    const float* xin; const bf16_t* xinb; bf16_t* xb; float* ssq;
    __device__ __forceinline__ void operator()(const f32x4 (&acc)[2][2][4][2], const Unit& u, int wr, int wc, int fr, int fq) const {
        const int row0 = u.pm * BM + wr * 64 + fr; const int cb = u.pn * BM + wc * 32 + 8 * fq;
#pragma unroll
        for (int ai = 0; ai < 2; ++ai) {
            f32x4 xv[4][2][2];
#pragma unroll
            for (int m = 0; m < 4; ++m)
#pragma unroll
                for (int bj = 0; bj < 2; ++bj) { const size_t o = (size_t)(row0 + ai * HALF + m * 16) * DM + cb + bj * HALF;
                    if (XIN_F32) { xv[m][bj][0] = *(const f32x4*)(xin + o); xv[m][bj][1] = *(const f32x4*)(xin + o + 4); }
                    else { const u32x4 w = *(const u32x4*)(xinb + o); xv[m][bj][0] = __builtin_bit_cast(f32x4, w); } }
            asm volatile("s_waitcnt vmcnt(0)" ::: "memory");
#pragma unroll
            for (int m = 0; m < 4; ++m)
#pragma unroll
                for (int bj = 0; bj < 2; ++bj) { asm volatile("" : "+v"(xv[m][bj][0])); if (XIN_F32) asm volatile("" : "+v"(xv[m][bj][1])); }
#pragma unroll
            for (int m = 0; m < 4; ++m) { const int row = row0 + ai * HALF + m * 16;
                float ss = 0.f;
#pragma unroll
                for (int bj = 0; bj < 2; ++bj) { const size_t o = (size_t)row * DM + cb + bj * HALF;
                    f32x4 v0, v1;
                    if (XIN_F32) { v0 = xv[m][bj][0]; v1 = xv[m][bj][1]; }
                    else { const u32x4 w = __builtin_bit_cast(u32x4, xv[m][bj][0]); v0 = (f32x4){bflo(w.x), bfhi(w.x), bflo(w.y), bfhi(w.y)}; v1 = (f32x4){bflo(w.z), bfhi(w.z), bflo(w.w), bfhi(w.w)}; }
                    v0 += acc[ai][bj][m][0]; v1 += acc[ai][bj][m][1];
                    *(u32x4*)(xb + o) = pack8(v0, v1);
                    ss += (v0[0] * v0[0] + v0[1] * v0[1]) + (v0[2] * v0[2] + v0[3] * v0[3]) + (v1[0] * v1[0] + v1[1] * v1[1]) + (v1[2] * v1[2] + v1[3] * v1[3]); }
                ss += __shfl_xor(ss, 16); ss += __shfl_xor(ss, 32);
                if (fq == 0) unsafeAtomicAdd(ssq + row, ss);
            }
        }
    }
};


struct EpiSoftmax {
    bf16_t* P; const float* ssq; LAS float* red;
    __device__ __forceinline__ void operator()(f32x4 (&acc)[2][2][4][2], const Unit& u, int wr, int wc, int fr, int fq) const {
        float mrow[2][4];
        EPI_LOAD_ROWSCALE(ssv, ssq)
        { EPI_ROWS_BEGIN
            (void)row; const float s = __builtin_amdgcn_rsqf(ssv[ai][m] * (1.f / DM) + EPS);
            float mx = -1e30f;
#pragma unroll
            for (int bj = 0; bj < 2; ++bj)
#pragma unroll
                for (int n = 0; n < 2; ++n) { acc[ai][bj][m][n] *= s;
#pragma unroll
                    for (int e = 0; e < 4; ++e) mx = fmaxf(mx, acc[ai][bj][m][n][e]); }
            mx = fmaxf(mx, __shfl_xor(mx, 16)); mx = fmaxf(mx, __shfl_xor(mx, 32));
            mrow[ai][m] = mx;
            if (fq == 0) red[(ai * HALF + wr * 64 + m * 16 + fr) * 4 + wc] = mx;
        } }
        __syncthreads();
        { EPI_ROWS_BEGIN
            (void)row;
            const f32x4 r4 = *(const LAS f32x4*)(red + (ai * HALF + wr * 64 + m * 16 + fr) * 4);
            const float mx = fmaxf(fmaxf(r4[0], r4[1]), fmaxf(r4[2], r4[3]));
            float sum = 0.f;
#pragma unroll
            for (int bj = 0; bj < 2; ++bj)
#pragma unroll
                for (int n = 0; n < 2; ++n)
#pragma unroll
                    for (int e = 0; e < 4; ++e) { const float p = fexp2(acc[ai][bj][m][n][e] - mx); acc[ai][bj][m][n][e] = p; sum += p; }
            sum += __shfl_xor(sum, 16); sum += __shfl_xor(sum, 32);
            mrow[ai][m] = sum;
            if (fq == 0) red[1024 + (ai * HALF + wr * 64 + m * 16 + fr) * 4 + wc] = sum;
        } }
        __syncthreads();
        { EPI_ROWS_BEGIN
            const f32x4 r4 = *(const LAS f32x4*)(red + 1024 + (ai * HALF + wr * 64 + m * 16 + fr) * 4);
            const float inv = frcp((r4[0] + r4[1]) + (r4[2] + r4[3]));
#pragma unroll
            for (int bj = 0; bj < 2; ++bj) { const int c = cb + bj * HALF;
                *(u32x4*)(P + (size_t)row * DM + c) = pack8(acc[ai][bj][m][0] * inv, acc[ai][bj][m][1] * inv); }
        } }
    }
};

struct EpiSwiGLU {
    bf16_t* ACT; const float* ssq;
    __device__ __forceinline__ void operator()(const f32x4 (&acc)[2][2][4][2], const Unit& u, int wr, int wc, int fr, int fq) const {
        EPI_LOAD_ROWSCALE(ssv, ssq)
        EPI_ROWS_BEGIN
            (void)row; const float s = __builtin_amdgcn_rsqf(ssv[ai][m] * (1.f / DM) + EPS);
#pragma unroll
            for (int bj = 0; bj < 2; ++bj) { const int c = cb + bj * HALF;
                const f32x4 v0 = acc[ai][bj][m][0] * s, v1 = acc[ai][bj][m][1] * s;
                const float a0 = v0[0] * fsigmoid(v0[0]) * v0[1], a1 = v0[2] * fsigmoid(v0[2]) * v0[3];
                const float a2 = v1[0] * fsigmoid(v1[0]) * v1[1], a3 = v1[2] * fsigmoid(v1[2]) * v1[3];
                u32x2 w; w.x = pk2(a0, a1); w.y = pk2(a2, a3);
                *(u32x2*)(ACT + (size_t)row * DFF + (c >> 1)) = w; }
        }
    }
};
}

namespace fa {
constexpr int BIAS_OFF = 98304, BIAS_COPY_N = 644, BIAS_COPY_BYTES = BIAS_COPY_N * 4;
#define MFMA32(a, b, c) __builtin_amdgcn_mfma_f32_32x32x16_bf16((a), (b), (c), 0, 0, 0)
__device__ __forceinline__ s16x4 vtr(LAS const unsigned char* p) { return __builtin_bit_cast(s16x4, __builtin_amdgcn_ds_read_tr16_b64_v4i16((LAS v4i16_t*)p)); }

template <int DQK, int DV, int MODE, bool QREG>
__device__ __forceinline__ void flash_pass(LAS unsigned char* lds, const bf16_t* Qw, int ldq, const bf16_t* Kb, int ldk, const bf16_t* Vb, int ldv,
                                           int t_lo, int t_hi, int w_lo, int w_hi, float csc, int qpos_w, f32x16 (&O)[DV / 32]) {
    constexpr int KP2 = (DQK + 8) * 2, VP2 = (DV + 32) * 2;
    constexpr int VOFF = 64 * KP2, BUFB = VOFF + 64 * VP2;
    static_assert(2 * BUFB <= BIAS_OFF, "stage buffers below the bias table");
    constexpr int KCH = DQK / 8, KN = 64 * KCH / 512, VCH = DV / 8, VN = 64 * VCH / 512;
    const int tid = threadIdx.x, lane = tid & 63, l31 = lane & 31, h = lane >> 5;
    const LAS float* bl = (const LAS float*)(lds + BIAS_OFF);
    bf16x8 Qf[QREG ? DQK / 16 : 1];
    const bf16_t* qbase = Qw + (size_t)l31 * ldq + h * 8;
    if (QREG) {
#pragma unroll
        for (int ks = 0; ks < DQK / 16; ++ks) Qf[ks] = *(const bf16x8*)(qbase + ks * 16);
    }
#pragma unroll
    for (int d = 0; d < DV / 32; ++d)
#pragma unroll
        for (int r = 0; r < 16; ++r) O[d][r] = 0.f;
    float mused = -1e30f, lsum = 0.f;
    u32x4 kreg[KN], vreg[VN];
#define FA_LOAD(t) do { \
        _Pragma("unroll") for (int i = 0; i < KN; ++i) { const int cid = tid + i * 512, r = cid / KCH, cc = cid % KCH; kreg[i] = *(const u32x4*)(Kb + (size_t)((t) * 64 + r) * ldk + cc * 8); } \
        _Pragma("unroll") for (int i = 0; i < VN; ++i) { const int cid = tid + i * 512, r = cid / VCH, cc = cid % VCH; vreg[i] = *(const u32x4*)(Vb + (size_t)((t) * 64 + r) * ldv + cc * 8); } } while (0)
#define FA_STORE(b) do { LAS unsigned char* _kb = lds + (b) * BUFB; \
        _Pragma("unroll") for (int i = 0; i < KN; ++i) { const int cid = tid + i * 512, r = cid / KCH, cc = cid % KCH; *(LAS u32x4*)(_kb + r * KP2 + cc * 16) = kreg[i]; } \
        _Pragma("unroll") for (int i = 0; i < VN; ++i) { const int cid = tid + i * 512, r = cid / VCH, cc = cid % VCH; *(LAS u32x4*)(_kb + VOFF + r * VP2 + cc * 16) = vreg[i]; } } while (0)
    FA_LOAD(t_lo);
    const int q4 = (lane & 15) >> 2, p4 = lane & 3, g16 = (lane >> 4) & 1;
    const int kp_off = l31 * KP2 + h * 16;
    const int vp_off = VOFF + (4 * h + q4) * VP2 + (16 * g16 + 4 * p4) * 2;
    FA_STORE(0);
    if (t_lo + 1 < t_hi) FA_LOAD(t_lo + 1);
    __syncthreads();
    for (int t = t_lo; t < t_hi; ++t) {
        const int cur = (t - t_lo) & 1;
        if (t + 1 < t_hi) { FA_STORE(cur ^ 1); if (t + 2 < t_hi) FA_LOAD(t + 2); }
        if (t >= w_lo && t < w_hi) {
            const LAS unsigned char* kp = lds + cur * BUFB + kp_off;
            const LAS unsigned char* vp = lds + cur * BUFB + vp_off;
            f32x16 s0, s1;
#pragma unroll
            for (int r = 0; r < 16; ++r) { s0[r] = 0.f; s1[r] = 0.f; }
            const bf16_t* qp = qbase;
            if (!QREG) asm volatile("" : "+v"(qp));
#pragma unroll
            for (int ks = 0; ks < DQK / 16; ++ks) {
                const bf16x8 a0 = *(const LAS bf16x8*)(kp + ks * 32);
                const bf16x8 a1 = *(const LAS bf16x8*)(kp + 32 * KP2 + ks * 32);
                const bf16x8 qf = QREG ? Qf[ks] : *(const bf16x8*)(qp + ks * 16);
                s0 = MFMA32(a0, qf, s0); s1 = MFMA32(a1, qf, s1);
            }
            float mx;
            if (MODE == 1) {
                const int rel0 = qpos_w + l31 - (t * 64 + 4 * h);
                if (qpos_w - (t * 64 + 63) >= 256) { const float bc = bl[512];
#pragma unroll
                    for (int r = 0; r < 16; ++r) { s0[r] = s0[r] * csc + bc; s1[r] = s1[r] * csc + bc; }
                } else {
#pragma unroll
                    for (int r = 0; r < 16; ++r) {
                        int i0 = rel0 - 8 * (r >> 2) - (r & 3); int i1 = i0 - 32;
                        i0 = min(max(i0, -256), 256) + 256; i1 = min(max(i1, -256), 256) + 256;
                        s0[r] = s0[r] * csc + bl[i0]; s1[r] = s1[r] * csc + bl[i1]; }
                }
                mx = fmaxf(s0[0], s1[0]);
#pragma unroll
                for (int r = 1; r < 16; ++r) mx = fmaxf(mx, fmaxf(s0[r], s1[r]));
            } else {
                mx = fmaxf(s0[0], s1[0]);
#pragma unroll
                for (int r = 1; r < 16; ++r) mx = fmaxf(mx, fmaxf(s0[r], s1[r]));
                mx *= csc;
            }
            mx = fmaxf(mx, __shfl_xor(mx, 32));
            if (__any(mx > mused + 8.f)) {
                const float mn = fmaxf(mused, mx), alpha = fexp2(mused - mn); mused = mn; lsum *= alpha;
#pragma unroll
                for (int d = 0; d < DV / 32; ++d)
#pragma unroll
                    for (int r = 0; r < 16; ++r) O[d][r] *= alpha;
            }
            float rs = 0.f;
            if (MODE == 1) {
#pragma unroll
                for (int r = 0; r < 16; ++r) { s0[r] = fexp2(s0[r] - mused); s1[r] = fexp2(s1[r] - mused); rs += s0[r] + s1[r]; }
            } else {
                const float nm = -mused;
#pragma unroll
                for (int r = 0; r < 16; ++r) { s0[r] = fexp2(__builtin_fmaf(s0[r], csc, nm)); s1[r] = fexp2(__builtin_fmaf(s1[r], csc, nm)); rs += s0[r] + s1[r]; }
            }
            lsum += rs;
            bf16x8 pb[4];
#pragma unroll
            for (int sp = 0; sp < 2; ++sp) {
                u32x4 w0, w1;
                w0.x = pk2(s0[8 * sp + 0], s0[8 * sp + 1]); w0.y = pk2(s0[8 * sp + 2], s0[8 * sp + 3]); w0.z = pk2(s0[8 * sp + 4], s0[8 * sp + 5]); w0.w = pk2(s0[8 * sp + 6], s0[8 * sp + 7]);
                w1.x = pk2(s1[8 * sp + 0], s1[8 * sp + 1]); w1.y = pk2(s1[8 * sp + 2], s1[8 * sp + 3]); w1.z = pk2(s1[8 * sp + 4], s1[8 * sp + 5]); w1.w = pk2(s1[8 * sp + 6], s1[8 * sp + 7]);
                pb[sp] = __builtin_bit_cast(bf16x8, w0); pb[2 + sp] = __builtin_bit_cast(bf16x8, w1);
            }
#pragma unroll
            for (int ks = 0; ks < 4; ++ks) {
#pragma unroll
                for (int d = 0; d < DV / 32; ++d) {
                    const s16x4 r0 = vtr(vp + (16 * ks) * VP2 + d * 64);
                    const s16x4 r1 = vtr(vp + (16 * ks + 8) * VP2 + d * 64);
                    const bf16x8 vf = {r0[0], r0[1], r0[2], r0[3], r1[0], r1[1], r1[2], r1[3]};
                    O[d] = MFMA32(vf, pb[ks], O[d]);
                }
            }
        }
        __syncthreads();
    }
#undef FA_LOAD
#undef FA_STORE
    lsum += __shfl_xor(lsum, 32);
    const float inv = 1.f / lsum;
#pragma unroll
    for (int d = 0; d < DV / 32; ++d)
#pragma unroll
        for (int r = 0; r < 16; ++r) O[d][r] *= inv;
}


template <int DV, int MODE>
__device__ __forceinline__ void flash_pass_dma(LAS unsigned char* lds, const bf16_t* Qw, int ldq, const bf16_t* Kb, int ldk, const bf16_t* Vb, int ldv,
                                               int t_lo, int t_hi, int w_lo, int w_hi, float csc, int qpos_w, f32x16 (&O)[DV / 32]) {
    constexpr int KBYTES = 8192, VROW = DV * 2, BUF = KBYTES + 64 * VROW, VOPS = DV / 64, OPS = 1 + VOPS;
    static_assert(4 * BUF <= BIAS_OFF, "ring below the bias table");
    const int tid = threadIdx.x, lane = tid & 63, l31 = lane & 31, h = lane >> 5, wave = __builtin_amdgcn_readfirstlane(tid >> 6);
    const LAS float* bl = (const LAS float*)(lds + BIAS_OFF);
    bf16x8 Qf[4];
    const bf16_t* qbase = Qw + (size_t)l31 * ldq + h * 8;
#pragma unroll
    for (int ks = 0; ks < 4; ++ks) Qf[ks] = *(const bf16x8*)(qbase + ks * 16);
#pragma unroll
    for (int d = 0; d < DV / 32; ++d)
#pragma unroll
        for (int r = 0; r < 16; ++r) O[d][r] = 0.f;
    float mused = -1e30f, lsum = 0.f;
    unsigned koff, voff[VOPS];
    { const int r = 8 * wave + (lane >> 3), p = lane & 7, c = p ^ ((r >> 1) & 7); koff = (unsigned)(r * ldk + c * 8); }
    if (DV == 128) {
#pragma unroll
        for (int i = 0; i < VOPS; ++i) { const int j = wave * 2 + i, r = 4 * j + (lane >> 4), p = lane & 15, c = p ^ ((r & 3) << 2); voff[i] = (unsigned)(r * ldv + c * 8); }
    } else { const int r = 8 * wave + (lane >> 3), p = lane & 7, c = p ^ (((r >> 1) & 1) << 2); voff[0] = (unsigned)(r * ldv + c * 8); }
#define FD_ISSUE(t, b) do { \
        __builtin_amdgcn_global_load_lds((const unsigned*)(Kb + (size_t)(t) * 64 * ldk + koff), (LAS unsigned*)(lds + (b) * BUF + wave * 1024), 16, 0, 0); \
        _Pragma("unroll") for (int i = 0; i < VOPS; ++i) __builtin_amdgcn_global_load_lds((const unsigned*)(Vb + (size_t)(t) * 64 * ldv + voff[i]), (LAS unsigned*)(lds + (b) * BUF + KBYTES + (wave * VOPS + i) * 1024), 16, 0, 0); } while (0)
    asm volatile("s_waitcnt vmcnt(0)" ::: "memory");
#pragma unroll
    for (int ks = 0; ks < 4; ++ks) asm volatile("" : "+v"(Qf[ks]));
    __builtin_amdgcn_s_barrier();
    asm volatile("" ::: "memory");
    FD_ISSUE(t_lo, 0);
    if (t_lo + 1 < t_hi) FD_ISSUE(t_lo + 1, 1);
    if (t_lo + 2 < t_hi) FD_ISSUE(t_lo + 2, 2);
    const int q4 = (lane & 15) >> 2, p4 = lane & 3, g16 = (lane >> 4) & 1;
    const int yk = (h ^ ((l31 >> 1) & 7)) << 4;
    const int kp_off = l31 * 128;
    const int vp_off = KBYTES + (4 * h + q4) * VROW + g16 * 32 + p4 * 8;
    const int vx = (DV == 128) ? (q4 * 64) : (((q4 >> 1) & 1) * 64);
#pragma unroll 1
    for (int t = t_lo; t < t_hi; ++t) {
        const int rem = t_hi - 1 - t;
        if (rem >= 2) { if (OPS == 3) asm volatile("s_waitcnt vmcnt(6)" ::: "memory"); else asm volatile("s_waitcnt vmcnt(4)" ::: "memory"); }
        else if (rem == 1) { if (OPS == 3) asm volatile("s_waitcnt vmcnt(3)" ::: "memory"); else asm volatile("s_waitcnt vmcnt(2)" ::: "memory"); }
        else asm volatile("s_waitcnt vmcnt(0)" ::: "memory");
        asm volatile("s_waitcnt lgkmcnt(0)" ::: "memory");
        __builtin_amdgcn_s_barrier();
        asm volatile("" ::: "memory");
        if (t + 3 < t_hi) FD_ISSUE(t + 3, (t + 3 - t_lo) & 3);
        if (t >= w_lo && t < w_hi) {
            const LAS unsigned char* bufp = lds + ((t - t_lo) & 3) * BUF;
            const LAS unsigned char* kp = bufp + kp_off;
            const LAS unsigned char* vp = bufp + vp_off;
            f32x16 s0, s1;
#pragma unroll
            for (int r = 0; r < 16; ++r) { s0[r] = 0.f; s1[r] = 0.f; }
#pragma unroll
            for (int ks = 0; ks < 4; ++ks) {
                const bf16x8 a0 = *(const LAS bf16x8*)(kp + ((ks * 32) ^ yk));
                const bf16x8 a1 = *(const LAS bf16x8*)(kp + 32 * 128 + ((ks * 32) ^ yk));
                s0 = MFMA32(a0, Qf[ks], s0); s1 = MFMA32(a1, Qf[ks], s1);
            }
            float mx;
            if (MODE == 1) {
                const int V00 = 575 - (qpos_w + l31 - (t * 64 + 4 * h));
                const LAS unsigned char* bp = (const LAS unsigned char*)bl + (V00 & 3) * BIAS_COPY_BYTES + (V00 & ~3) * 4;
#pragma unroll
                for (int j = 0; j < 4; ++j) {
                    const f32x4 b0 = *(const LAS f32x4*)(bp + (8 * j) * 4), b1 = *(const LAS f32x4*)(bp + (32 + 8 * j) * 4);
#pragma unroll
                    for (int i = 0; i < 4; ++i) { s0[4 * j + i] = s0[4 * j + i] * csc + b0[i]; s1[4 * j + i] = s1[4 * j + i] * csc + b1[i]; }
                }
                mx = fmaxf(s0[0], s1[0]);
#pragma unroll
                for (int r = 1; r < 16; ++r) mx = fmaxf(mx, fmaxf(s0[r], s1[r]));
            } else {
                mx = fmaxf(s0[0], s1[0]);
#pragma unroll
                for (int r = 1; r < 16; ++r) mx = fmaxf(mx, fmaxf(s0[r], s1[r]));
                mx *= csc;
            }
            mx = fmaxf(mx, __shfl_xor(mx, 32));
            if (__any(mx > mused + 8.f)) {
                const float mn = fmaxf(mused, mx), alpha = fexp2(mused - mn); mused = mn; lsum *= alpha;
#pragma unroll
                for (int d = 0; d < DV / 32; ++d)
#pragma unroll
                    for (int r = 0; r < 16; ++r) O[d][r] *= alpha;
            }
            float rs = 0.f;
            if (MODE == 1) {
#pragma unroll
                for (int r = 0; r < 16; ++r) { s0[r] = fexp2(s0[r] - mused); s1[r] = fexp2(s1[r] - mused); rs += s0[r] + s1[r]; }
            } else {
                const float nm = -mused;
#pragma unroll
                for (int r = 0; r < 16; ++r) { s0[r] = fexp2(__builtin_fmaf(s0[r], csc, nm)); s1[r] = fexp2(__builtin_fmaf(s1[r], csc, nm)); rs += s0[r] + s1[r]; }
            }
            lsum += rs;
            bf16x8 pb[4];
#pragma unroll
            for (int sp = 0; sp < 2; ++sp) {
                u32x4 w0, w1;
                w0.x = pk2(s0[8 * sp + 0], s0[8 * sp + 1]); w0.y = pk2(s0[8 * sp + 2], s0[8 * sp + 3]); w0.z = pk2(s0[8 * sp + 4], s0[8 * sp + 5]); w0.w = pk2(s0[8 * sp + 6], s0[8 * sp + 7]);
                w1.x = pk2(s1[8 * sp + 0], s1[8 * sp + 1]); w1.y = pk2(s1[8 * sp + 2], s1[8 * sp + 3]); w1.z = pk2(s1[8 * sp + 4], s1[8 * sp + 5]); w1.w = pk2(s1[8 * sp + 6], s1[8 * sp + 7]);
                pb[sp] = __builtin_bit_cast(bf16x8, w0); pb[2 + sp] = __builtin_bit_cast(bf16x8, w1);
            }
#pragma unroll
            for (int ks = 0; ks < 4; ++ks) {
#pragma unroll
                for (int d = 0; d < DV / 32; ++d) {
                    const s16x4 r0 = vtr(vp + (16 * ks) * VROW + ((d * 64) ^ vx));
                    const s16x4 r1 = vtr(vp + (16 * ks + 8) * VROW + ((d * 64) ^ vx));
                    const bf16x8 vf = {r0[0], r0[1], r0[2], r0[3], r1[0], r1[1], r1[2], r1[3]};
                    O[d] = MFMA32(vf, pb[ks], O[d]);
                }
            }
        }
    }
#undef FD_ISSUE
    lsum += __shfl_xor(lsum, 32);
    const float inv = 1.f / lsum;
#pragma unroll
    for (int d = 0; d < DV / 32; ++d)
#pragma unroll
        for (int r = 0; r < 16; ++r) O[d][r] *= inv;
}


__device__ __forceinline__ void cross_pass(LAS unsigned char* lds, const bf16_t* Qw, const bf16_t* Kb, const bf16_t* Vb, float csc, f32x16 (&O)[4]) {
    constexpr int LDK = 2048, KBYTES = 32768, BUF = 49152;
    const int tid = threadIdx.x, lane = tid & 63, l31 = lane & 31, h = lane >> 5, wave = __builtin_amdgcn_readfirstlane(tid >> 6);
    bf16x8 Qf[16];
    const bf16_t* qbase = Qw + (size_t)l31 * DM + h * 8;
#pragma unroll
    for (int ks = 0; ks < 16; ++ks) Qf[ks] = *(const bf16x8*)(qbase + ks * 16);
#pragma unroll
    for (int d = 0; d < 4; ++d)
#pragma unroll
        for (int r = 0; r < 16; ++r) O[d][r] = 0.f;
    float mused = -1e30f, lsum = 0.f;
    unsigned koff[4], voff[2];
#pragma unroll
    for (int i = 0; i < 4; ++i) { const int j = wave * 4 + i, r = 2 * j + (lane >> 5), p = lane & 31, c = p ^ (r & 31); koff[i] = (unsigned)(r * LDK + c * 8); }
#pragma unroll
    for (int i = 0; i < 2; ++i) { const int j = wave * 2 + i, r = 4 * j + (lane >> 4), p = lane & 15, c = p ^ ((r & 3) << 2); voff[i] = (unsigned)(r * LDK + c * 8); }
#define CX_ISSUE(t, b) do { \
        _Pragma("unroll") for (int i = 0; i < 4; ++i) __builtin_amdgcn_global_load_lds((const unsigned*)(Kb + (size_t)(t) * 64 * LDK + koff[i]), (LAS unsigned*)(lds + (b) * BUF + (wave * 4 + i) * 1024), 16, 0, 0); \
        _Pragma("unroll") for (int i = 0; i < 2; ++i) __builtin_amdgcn_global_load_lds((const unsigned*)(Vb + (size_t)(t) * 64 * LDK + voff[i]), (LAS unsigned*)(lds + (b) * BUF + KBYTES + (wave * 2 + i) * 1024), 16, 0, 0); } while (0)
    asm volatile("s_waitcnt vmcnt(0)" ::: "memory");
#pragma unroll
    for (int ks = 0; ks < 16; ++ks) asm volatile("" : "+v"(Qf[ks]));
    __builtin_amdgcn_s_barrier();
    asm volatile("" ::: "memory");
    CX_ISSUE(0, 0); CX_ISSUE(1, 1);
    const int q4 = (lane & 15) >> 2, p4 = lane & 3, g16 = (lane >> 4) & 1;
    const int yy = (h ^ l31) << 4;
    const int kp_off = l31 * 512;
    const int vp_off = KBYTES + (4 * h + q4) * 256 + g16 * 32 + p4 * 8;
    const int q64 = q4 * 64;
#pragma unroll 1
    for (int t = 0; t < 4; ++t) {
        if (t < 3) asm volatile("s_waitcnt vmcnt(6)" ::: "memory"); else asm volatile("s_waitcnt vmcnt(0)" ::: "memory");
        __builtin_amdgcn_s_barrier();
        asm volatile("" ::: "memory");
        const LAS unsigned char* kp = lds + (t & 1) * BUF + kp_off;
        const LAS unsigned char* vp = lds + (t & 1) * BUF + vp_off;
        f32x16 s0, s1;
#pragma unroll
        for (int r = 0; r < 16; ++r) { s0[r] = 0.f; s1[r] = 0.f; }
#pragma unroll
        for (int ks = 0; ks < 16; ++ks) {
            const bf16x8 a0 = *(const LAS bf16x8*)(kp + ((ks * 32) ^ yy));
            const bf16x8 a1 = *(const LAS bf16x8*)(kp + 32 * 512 + ((ks * 32) ^ yy));
            const bf16x8 qf = Qf[ks];
            s0 = MFMA32(a0, qf, s0); s1 = MFMA32(a1, qf, s1);
        }
        float mx = fmaxf(s0[0], s1[0]);
#pragma unroll
        for (int r = 1; r < 16; ++r) mx = fmaxf(mx, fmaxf(s0[r], s1[r]));
        mx *= csc;
        mx = fmaxf(mx, __shfl_xor(mx, 32));
        if (__any(mx > mused + 8.f)) {
            const float mn = fmaxf(mused, mx), alpha = fexp2(mused - mn); mused = mn; lsum *= alpha;
#pragma unroll
            for (int d = 0; d < 4; ++d)
#pragma unroll
                for (int r = 0; r < 16; ++r) O[d][r] *= alpha;
        }
        float rs = 0.f; const float nm = -mused;
#pragma unroll
        for (int r = 0; r < 16; ++r) { s0[r] = fexp2(__builtin_fmaf(s0[r], csc, nm)); s1[r] = fexp2(__builtin_fmaf(s1[r], csc, nm)); rs += s0[r] + s1[r]; }
        lsum += rs;
        bf16x8 pb[4];
#pragma unroll
        for (int sp = 0; sp < 2; ++sp) {
            u32x4 w0, w1;
            w0.x = pk2(s0[8 * sp + 0], s0[8 * sp + 1]); w0.y = pk2(s0[8 * sp + 2], s0[8 * sp + 3]); w0.z = pk2(s0[8 * sp + 4], s0[8 * sp + 5]); w0.w = pk2(s0[8 * sp + 6], s0[8 * sp + 7]);
            w1.x = pk2(s1[8 * sp + 0], s1[8 * sp + 1]); w1.y = pk2(s1[8 * sp + 2], s1[8 * sp + 3]); w1.z = pk2(s1[8 * sp + 4], s1[8 * sp + 5]); w1.w = pk2(s1[8 * sp + 6], s1[8 * sp + 7]);
            pb[sp] = __builtin_bit_cast(bf16x8, w0); pb[2 + sp] = __builtin_bit_cast(bf16x8, w1);
        }
#pragma unroll
        for (int ks = 0; ks < 4; ++ks) {
#pragma unroll
            for (int d = 0; d < 4; ++d) {
                const s16x4 r0 = vtr(vp + (16 * ks) * 256 + ((d * 64) ^ q64));
                const s16x4 r1 = vtr(vp + (16 * ks + 8) * 256 + ((d * 64) ^ q64));
                const bf16x8 vf = {r0[0], r0[1], r0[2], r0[3], r1[0], r1[1], r1[2], r1[3]};
                O[d] = MFMA32(vf, pb[ks], O[d]);
            }
        }
        if (t + 2 < 4) {
            asm volatile("s_waitcnt lgkmcnt(0)" ::: "memory");
            __builtin_amdgcn_s_barrier();
            asm volatile("" ::: "memory");
            CX_ISSUE(t + 2, t & 1);
        }
    }
#undef CX_ISSUE
    lsum += __shfl_xor(lsum, 32);
    const float inv = 1.f / lsum;
#pragma unroll
    for (int d = 0; d < 4; ++d)
#pragma unroll
        for (int r = 0; r < 16; ++r) O[d][r] *= inv;
}


__device__ __forceinline__ void cross_unit(LAS unsigned char* lds, const bf16_t* Qw, const bf16_t* Kb, const bf16_t* Vb, float csc, bf16_t* orow  ) {
    constexpr int LDK = 2048, TB = 32768;
    const int tid = threadIdx.x, lane = tid & 63, l31 = lane & 31, h = lane >> 5, wave = __builtin_amdgcn_readfirstlane(tid >> 6);
    bf16x8 Qf[16];
    const bf16_t* qbase = Qw + (size_t)l31 * DM + h * 8;
#pragma unroll
    for (int ks = 0; ks < 16; ++ks) Qf[ks] = *(const bf16x8*)(qbase + ks * 16);
    unsigned koff[4], voff[4];
#pragma unroll
    for (int i = 0; i < 4; ++i) { const int j = wave * 4 + i, r = 2 * j + (lane >> 5), p = lane & 31; koff[i] = (unsigned)(r * LDK + (p ^ (r & 31)) * 8); voff[i] = (unsigned)(r * LDK + (p ^ ((r & 3) << 2)) * 8); }
    asm volatile("s_waitcnt vmcnt(0)" ::: "memory");
#pragma unroll
    for (int ks = 0; ks < 16; ++ks) asm volatile("" : "+v"(Qf[ks]));
    asm volatile("s_waitcnt lgkmcnt(0)" ::: "memory");
    __builtin_amdgcn_s_barrier();
    asm volatile("" ::: "memory");
#pragma unroll
    for (int t = 0; t < 4; ++t)
#pragma unroll
        for (int i = 0; i < 4; ++i) __builtin_amdgcn_global_load_lds((const unsigned*)(Kb + (size_t)t * 64 * LDK + koff[i]), (LAS unsigned*)(lds + t * TB + (wave * 4 + i) * 1024), 16, 0, 0);
    asm volatile("s_waitcnt vmcnt(0)" ::: "memory");
    __builtin_amdgcn_s_barrier();
    asm volatile("" ::: "memory");
    const int yy = (h ^ l31) << 4;
    f32x16 S[4][2];
#pragma unroll
    for (int t = 0; t < 4; ++t) {
        const LAS unsigned char* kp = lds + t * TB + l31 * 512;
#pragma unroll
        for (int r = 0; r < 16; ++r) { S[t][0][r] = 0.f; S[t][1][r] = 0.f; }
#pragma unroll
        for (int ks = 0; ks < 16; ++ks) {
            const bf16x8 a0 = *(const LAS bf16x8*)(kp + ((ks * 32) ^ yy));
            const bf16x8 a1 = *(const LAS bf16x8*)(kp + 32 * 512 + ((ks * 32) ^ yy));
            S[t][0] = MFMA32(a0, Qf[ks], S[t][0]); S[t][1] = MFMA32(a1, Qf[ks], S[t][1]);
        }
    }
    asm volatile("s_waitcnt lgkmcnt(0)" ::: "memory");
    __builtin_amdgcn_s_barrier();
    asm volatile("" ::: "memory");
#pragma unroll
    for (int t = 0; t < 4; ++t)
#pragma unroll
        for (int i = 0; i < 4; ++i) __builtin_amdgcn_global_load_lds((const unsigned*)(Vb + (size_t)t * 64 * LDK + voff[i]), (LAS unsigned*)(lds + t * TB + (wave * 4 + i) * 1024), 16, 0, 0);
    float mx = fmaxf(S[0][0][0], S[0][1][0]);
#pragma unroll
    for (int t = 0; t < 4; ++t)
#pragma unroll
        for (int r = 0; r < 16; ++r) mx = fmaxf(mx, fmaxf(S[t][0][r], S[t][1][r]));
    mx = fmaxf(mx, __shfl_xor(mx, 32));
    const float nm = -mx * csc;
    float lsum = 0.f;
    bf16x8 pb[4][4];
#pragma unroll
    for (int t = 0; t < 4; ++t) {
#pragma unroll
        for (int r = 0; r < 16; ++r) { S[t][0][r] = fexp2(__builtin_fmaf(S[t][0][r], csc, nm)); S[t][1][r] = fexp2(__builtin_fmaf(S[t][1][r], csc, nm)); lsum += S[t][0][r] + S[t][1][r]; }
#pragma unroll
        for (int sp = 0; sp < 2; ++sp) {
            u32x4 w0, w1;
            w0.x = pk2(S[t][0][8 * sp + 0], S[t][0][8 * sp + 1]); w0.y = pk2(S[t][0][8 * sp + 2], S[t][0][8 * sp + 3]); w0.z = pk2(S[t][0][8 * sp + 4], S[t][0][8 * sp + 5]); w0.w = pk2(S[t][0][8 * sp + 6], S[t][0][8 * sp + 7]);
            w1.x = pk2(S[t][1][8 * sp + 0], S[t][1][8 * sp + 1]); w1.y = pk2(S[t][1][8 * sp + 2], S[t][1][8 * sp + 3]); w1.z = pk2(S[t][1][8 * sp + 4], S[t][1][8 * sp + 5]); w1.w = pk2(S[t][1][8 * sp + 6], S[t][1][8 * sp + 7]);
            pb[t][sp] = __builtin_bit_cast(bf16x8, w0); pb[t][2 + sp] = __builtin_bit_cast(bf16x8, w1);
        }
    }
    lsum += __shfl_xor(lsum, 32);
    const float inv = 1.f / lsum;
    asm volatile("s_waitcnt vmcnt(0)" ::: "memory");
    __builtin_amdgcn_s_barrier();
    asm volatile("" ::: "memory");
    const int q4 = (lane & 15) >> 2, p4 = lane & 3, g16 = (lane >> 4) & 1, q64 = q4 * 64;
    const int vp_off = (4 * h + q4) * 512 + g16 * 32 + p4 * 8;
#pragma unroll 1
    for (int half = 0; half < 2; ++half) {
        f32x16 O[4];
#pragma unroll
        for (int d = 0; d < 4; ++d)
#pragma unroll
            for (int r = 0; r < 16; ++r) O[d][r] = 0.f;
#pragma unroll
        for (int t = 0; t < 4; ++t) {
            const LAS unsigned char* vp = lds + t * TB + vp_off + half * 256;
#pragma unroll
            for (int ks = 0; ks < 4; ++ks) {
#pragma unroll
                for (int d = 0; d < 4; ++d) {
                    const s16x4 r0 = vtr(vp + (16 * ks) * 512 + ((d * 64) ^ q64));
                    const s16x4 r1 = vtr(vp + (16 * ks + 8) * 512 + ((d * 64) ^ q64));
                    const bf16x8 vf = __builtin_shufflevector(r0, r1, 0, 1, 2, 3, 4, 5, 6, 7);
                    O[d] = MFMA32(vf, pb[t][ks], O[d]);
                }
            }
        }
#pragma unroll
        for (int d = 0; d < 4; ++d)
#pragma unroll
            for (int j = 0; j < 4; ++j) { u32x2 w; w.x = pk2(O[d][4 * j] * inv, O[d][4 * j + 1] * inv); w.y = pk2(O[d][4 * j + 2] * inv, O[d][4 * j + 3] * inv);
                *(u32x2*)(orow + half * 128 + 32 * d + 8 * j + 4 * h) = w; }
    }
}

template <int NB> __device__ __forceinline__ void store_ot(const f32x16 (&O)[NB], bf16_t* orow  , int h) {
#pragma unroll
    for (int d = 0; d < NB; ++d)
#pragma unroll
        for (int j = 0; j < 4; ++j) { u32x2 w; w.x = pk2(O[d][4 * j], O[d][4 * j + 1]); w.y = pk2(O[d][4 * j + 2], O[d][4 * j + 3]);
            *(u32x2*)(orow + 32 * d + 8 * j + 4 * h) = w; }
}
}


#define XB_TMO      128
#define XB_XCNT(j)  (256  + 64 * (j))
#define XB_XSUB(j)  (1280 + 64 * (j))
#define XB_XGEN(j)  (2304 + 64 * (j))
#define XB_TOP      3328
#define XB_TOPGEN   3392
#define XCD_BAR_WORDS 3456
#define XB_SPIN_CAP (1u << 22)
__device__ __forceinline__ unsigned xb_ld(unsigned* p)              { return __hip_atomic_load(p, __ATOMIC_RELAXED, __HIP_MEMORY_SCOPE_AGENT); }
__device__ __forceinline__ unsigned xb_add(unsigned* p, unsigned v) { return __hip_atomic_fetch_add(p, v, __ATOMIC_RELAXED, __HIP_MEMORY_SCOPE_AGENT); }
__device__ __forceinline__ unsigned xb_xcc_id() { return (unsigned)__builtin_amdgcn_s_getreg((3 << 11) | 20) & 0xFu; }
#define XB_SPIN(cond, bar) do { unsigned _sp = 0; while (cond) { __builtin_amdgcn_s_sleep(1); \
    if ((++_sp & 255u) == 0u) { if (xb_ld(&(bar)[XB_TMO])) break; if (_sp > XB_SPIN_CAP) { atomicAdd(&(bar)[XB_TMO], 1u); break; } } } } while (0)
struct XcdBarrier { unsigned* bar; unsigned x; volatile LAS unsigned* st; };
__device__ __forceinline__ XcdBarrier xcd_barrier_post(unsigned* bar, volatile LAS unsigned* st) {
    XcdBarrier b; b.bar = bar; b.x = xb_xcc_id(); b.st = st;
    if (threadIdx.x == 0) (void)xb_add(&bar[XB_XCNT(b.x)], 1u);
    return b;
}
__device__ __forceinline__ void xcd_barrier_complete(unsigned* bar, unsigned x, unsigned& nloc, unsigned& nx) {
    const unsigned G = gridDim.x * gridDim.y * gridDim.z;
    unsigned sum, cnt, mine, sp = 0u;
    for (;;) {
        sum = 0u; cnt = 0u; mine = 0u;
#pragma unroll
        for (unsigned j = 0; j < 16; ++j) { const unsigned c = xb_ld(&bar[XB_XCNT(j)]); sum += c; cnt += (c > 0u) ? 1u : 0u; mine = (j == x) ? c : mine; }
        if (sum == G) break;
        __builtin_amdgcn_s_sleep(1);
        if ((++sp & 255u) == 0u) { if (xb_ld(&bar[XB_TMO])) break; if (sp > XB_SPIN_CAP) { atomicAdd(&bar[XB_TMO], 1u); break; } }
    }
    nloc = mine > 0u ? mine : 1u; nx = cnt > 0u ? cnt : 1u;
}
__device__ __forceinline__ void xcd_barrier(const XcdBarrier& b) {
    asm volatile("s_waitcnt vmcnt(0)" ::: "memory");
    __syncthreads();
    if (threadIdx.x == 0) {
        unsigned* bar = b.bar;
        __builtin_amdgcn_s_waitcnt(0);
        unsigned nloc = b.st[0], nx = b.st[1];
        if (nloc == 0u) { xcd_barrier_complete(bar, b.x, nloc, nx); b.st[0] = nloc; b.st[1] = nx; }
        const unsigned old = xb_add(&bar[XB_XSUB(b.x)], 1u);
        const unsigned gen = old / nloc;
        if (old + 1u == (gen + 1u) * nloc) {
            __builtin_amdgcn_fence(__ATOMIC_RELEASE, "agent");
            asm volatile("s_waitcnt vmcnt(0)" ::: "memory");
            const unsigned og = xb_add(&bar[XB_TOP], 1u);
            const unsigned tg = og / nx;
            if (og + 1u == (tg + 1u) * nx) xb_add(&bar[XB_TOPGEN], 1u);
            else XB_SPIN(xb_ld(&bar[XB_TOPGEN]) == tg, bar);
            __builtin_amdgcn_fence(__ATOMIC_ACQUIRE, "agent");
            xb_add(&bar[XB_XGEN(b.x)], 1u);
            asm volatile("s_waitcnt vmcnt(0)" ::: "memory");
        } else {
            XB_SPIN(xb_ld(&bar[XB_XGEN(b.x)]) == gen, bar);
            __builtin_amdgcn_fence(__ATOMIC_ACQUIRE, "agent");
            asm volatile("s_waitcnt vmcnt(0)" ::: "memory");
        }
    }
    __syncthreads();
}

struct Args { const float* in[22]; float* out; unsigned char* ws; int ph_lo, ph_hi; };
constexpr int NWAVES = 8, LDS_BYTES = 147456, NPHASE = 11;

__device__ __forceinline__ void transpose_item(const float* W, int N, bf16_t* WT, int ldt, int k_off, LAS float* scr, int kb, int nb, int lane, const float* gain, int mapmode) {
    const int k0 = 64 * kb, n0 = 32 * nb;
    const int nn = n0 + (lane & 31);
    int src = nn;
    if (mapmode == 1) { if (nn < 1024) src = (nn & ~63) + ((nn & 63) >> 1) + 32 * (nn & 1); }
    else if (mapmode == 2) { src = (nn & 1) ? (DFF + (nn >> 1)) : (nn >> 1); }
    float wv[32];
#pragma unroll
    for (int i = 0; i < 32; ++i) { const int kk = 2 * i + (lane >> 5); wv[i] = __builtin_nontemporal_load(W + (size_t)(k0 + kk) * N + src); }
    if (gain) {
#pragma unroll
        for (int i = 0; i < 32; ++i) wv[i] *= gain[k0 + 2 * i + (lane >> 5)];
    }
#pragma unroll
    for (int i = 0; i < 32; ++i) { const int kk = 2 * i + (lane >> 5); scr[kk * 33 + (lane & 31)] = wv[i]; }
    asm volatile("s_waitcnt lgkmcnt(0)" ::: "memory");
    const int c = lane & 7;
#pragma unroll
    for (int j = 0; j < 4; ++j) { const int n = (lane >> 3) + 8 * j; const LAS float* s = scr + (8 * c) * 33 + n;
        u32x4 o; o.x = pk2(s[0 * 33], s[1 * 33]); o.y = pk2(s[2 * 33], s[3 * 33]); o.z = pk2(s[4 * 33], s[5 * 33]); o.w = pk2(s[6 * 33], s[7 * 33]);
        *(u32x4*)(WT + (size_t)(n0 + n) * ldt + k_off + k0 + 8 * c) = o; }
    asm volatile("s_waitcnt lgkmcnt(0)" ::: "memory");
}

__device__ __forceinline__ void row_to_bf16(const float* xrow, bf16_t* orow, float* rstd_out, int lane) {
    const f32x4* xr = (const f32x4*)xrow + lane;
    f32x4 v[4]; float s = 0.f;
#pragma unroll
    for (int j = 0; j < 4; ++j) { v[j] = xr[64 * j]; s += (v[j].x * v[j].x + v[j].y * v[j].y) + (v[j].z * v[j].z + v[j].w * v[j].w); }
    s = wave_sum(s);
    if (lane == 0) *rstd_out = 1.f / sqrtf(s * (1.f / DM) + EPS);
    u32x2* o8 = (u32x2*)orow + lane;
#pragma unroll
    for (int j = 0; j < 4; ++j) { u32x2 w; w.x = pk2(v[j].x, v[j].y); w.y = pk2(v[j].z, v[j].w); o8[64 * j] = w; }
}

__device__ __forceinline__ void row2_to_bf16(const float* xrow, bf16_t* orow, float* rstd_out, int lane, size_t rstride, int sstride, bool two) {
    const f32x4* xr = (const f32x4*)xrow + lane; const f32x4* xr2 = (const f32x4*)(xrow + (two ? rstride : 0)) + lane;
    f32x4 v[4], w[4]; float s = 0.f, s2 = 0.f;
#pragma unroll
    for (int j = 0; j < 4; ++j) { v[j] = xr[64 * j]; w[j] = xr2[64 * j]; }
#pragma unroll
    for (int j = 0; j < 4; ++j) { s += (v[j].x * v[j].x + v[j].y * v[j].y) + (v[j].z * v[j].z + v[j].w * v[j].w); s2 += (w[j].x * w[j].x + w[j].y * w[j].y) + (w[j].z * w[j].z + w[j].w * w[j].w); }
    s = wave_sum(s); s2 = wave_sum(s2);
    if (lane == 0) { rstd_out[0] = 1.f / sqrtf(s * (1.f / DM) + EPS); if (two) rstd_out[sstride] = 1.f / sqrtf(s2 * (1.f / DM) + EPS); }
    u32x2* o8 = (u32x2*)orow + lane;
#pragma unroll
    for (int j = 0; j < 4; ++j) { u32x2 p; p.x = pk2(v[j].x, v[j].y); p.y = pk2(v[j].z, v[j].w); o8[64 * j] = p; }
    if (two) { u32x2* o9 = (u32x2*)(orow + rstride) + lane;
#pragma unroll
        for (int j = 0; j < 4; ++j) { u32x2 p; p.x = pk2(w[j].x, w[j].y); p.y = pk2(w[j].z, w[j].w); o9[64 * j] = p; } }
}

__device__ __forceinline__ void row4_to_bf16(const float* xrow, bf16_t* orow, float* rstd_out, int lane, size_t rstride, int sstride) {
    f32x4 v[4][4]; float s[4];
#pragma unroll
    for (int q = 0; q < 4; ++q)
#pragma unroll
        for (int j = 0; j < 4; ++j) v[q][j] = __builtin_nontemporal_load((const f32x4*)(xrow + q * rstride) + lane + 64 * j);
#pragma unroll
    for (int q = 0; q < 4; ++q) { s[q] = 0.f;
#pragma unroll
        for (int j = 0; j < 4; ++j) s[q] += (v[q][j].x * v[q][j].x + v[q][j].y * v[q][j].y) + (v[q][j].z * v[q][j].z + v[q][j].w * v[q][j].w); }
#pragma unroll
    for (int o = 1; o < 64; o <<= 1) {
#pragma unroll
        for (int q = 0; q < 4; ++q) s[q] += __shfl_xor(s[q], o); }
    if (lane == 0) {
#pragma unroll
        for (int q = 0; q < 4; ++q) rstd_out[q * sstride] = 1.f / sqrtf(s[q] * (1.f / DM) + EPS); }
#pragma unroll
    for (int q = 0; q < 4; ++q) { u32x2* o8 = (u32x2*)(orow + q * rstride) + lane;
#pragma unroll
        for (int j = 0; j < 4; ++j) { u32x2 p; p.x = pk2(v[q][j].x, v[q][j].y); p.y = pk2(v[q][j].z, v[q][j].w); o8[64 * j] = p; } }
}

__device__ __forceinline__ double sin_poly(double r) {
    const double r2 = r * r; double t = 1.0, s = 1.0;
#pragma unroll
    for (int k = 1; k <= 14; ++k) { t *= -r2 / (double)((2 * k) * (2 * k + 1)); s += t; }
    return r * s;
}
__device__ __forceinline__ double cos_poly(double r) {
    const double r2 = r * r; double t = 1.0, s = 1.0;
#pragma unroll
    for (int k = 1; k <= 15; ++k) { t *= -r2 / (double)((2 * k - 1) * (2 * k)); s += t; }
    return s;
}

__global__ void __launch_bounds__(NWAVES * 64, 2) mk_fwd(Args args) {
    extern __shared__ __attribute__((aligned(16))) unsigned char lds_raw[];
    LAS unsigned char* lds = (LAS unsigned char*)lds_raw;
    const int tid = threadIdx.x, lane = tid & 63, wave = __builtin_amdgcn_readfirstlane(tid >> 6);
    const int G = gridDim.x, bx = blockIdx.x;
    unsigned char* ws = args.ws;
    float* stats = (float*)(ws + WS_STATS);
    const float* x = args.in[0]; const float* mem = args.in[1];
    bf16_t* WinT = (bf16_t*)(ws + WS_WIN); bf16_t* WupT = (bf16_t*)(ws + WS_WUP); bf16_t* WoutT = (bf16_t*)(ws + WS_WOUT); bf16_t* WcqT = (bf16_t*)(ws + WS_WCQ);
    bf16_t* WckvT = (bf16_t*)(ws + WS_WCKV); bf16_t* WcoT = (bf16_t*)(ws + WS_WCO); bf16_t* WguT = (bf16_t*)(ws + WS_WGU); bf16_t* WdT = (bf16_t*)(ws + WS_WD);
    bf16_t* KVX = (bf16_t*)(ws + WS_KVX); bf16_t* MEMB = (bf16_t*)(ws + WS_MEMB); bf16_t* XB = (bf16_t*)(ws + WS_XB); bf16_t* Y = XB;
    bf16_t* QKV = (bf16_t*)(ws + WS_QKV); bf16_t* T = (bf16_t*)(ws + WS_T); bf16_t* QX = (bf16_t*)(ws + WS_QX); bf16_t* OX = (bf16_t*)(ws + WS_OX);
    bf16_t* ACT = (bf16_t*)(ws + WS_ACT); bf16_t* GB = (bf16_t*)(ws + WS_G); bf16_t* X1B = (bf16_t*)(ws + WS_X1B); bf16_t* X2B = (bf16_t*)(ws + WS_X2B);
    float* out = args.out;
    const int lo = args.ph_lo, hi = args.ph_hi;
#ifndef PH_MASK
#define PH_MASK 0x7ff
#endif
#define IN(k) (((PH_MASK >> (k)) & 1) && lo <= (k) && (k) < hi)
#if ONE_LAUNCH
    volatile LAS unsigned* bst = (volatile LAS unsigned*)(lds + LDS_BYTES - 64);
    if (tid < 2) bst[tid] = 0u;
    __syncthreads();
    const XcdBarrier xbar = xcd_barrier_post((unsigned*)(ws + WS_CTL), bst);
#define SEAM(k) do { if (IN(k) && IN((k) + 1)) xcd_barrier(xbar); } while (0)
    if (args.ph_lo < 0) cg::this_grid().sync();
#else
#define SEAM(k) do { } while (0)
#endif

    if (IN(0)) for (int prb = 0; prb < REP_P0; ++prb) {
        LAS float* scr = (LAS float*)(lds + wave * 16384);
        const int gw = bx * NWAVES + wave, NGW = G * NWAVES;
        constexpr int I_IN = 16 * 160, I_UP = 8 * 32, I_SQ = 16 * 32, I_CKV = 16 * 64, I_GU = 16 * 176, I_D = 44 * 32;
        constexpr int NITEMS = I_IN + 2 * I_UP + 3 * I_SQ + I_CKV + I_GU + I_D;
        for (int it = gw; it < NITEMS; it += NGW) {
            int r = it;
            if (r < I_IN) { transpose_item(args.in[3], INC, WinT, DM, 0, scr, r / 160, r % 160, lane, args.in[2], 1); continue; } r -= I_IN;
            if (r < I_UP) { transpose_item(args.in[10], DM, WupT, DM, 0, scr, r / 32, r % 32, lane, nullptr, 0); continue; } r -= I_UP;
            if (r < I_UP) { transpose_item(args.in[11], DM, WupT, DM, 512, scr, r / 32, r % 32, lane, nullptr, 0); continue; } r -= I_UP;
            if (r < I_SQ) { transpose_item(args.in[12], DM, WoutT, DM, 0, scr, r / 32, r % 32, lane, nullptr, 0); continue; } r -= I_SQ;
            if (r < I_SQ) {
#pragma unroll
                for (int q = 0; q < 2; ++q) { const int k = 2 * r + q; const float gk = args.in[13][k]; const f32x4* wr_ = (const f32x4*)(args.in[15] + (size_t)k * DM) + lane; u32x2* o8 = (u32x2*)(WcqT + (size_t)k * DM) + lane;
#pragma unroll
                    for (int j = 0; j < 4; ++j) { const f32x4 v = wr_[64 * j] * gk; u32x2 w; w.x = pk2(v.x, v.y); w.y = pk2(v.z, v.w); o8[64 * j] = w; } }
                continue; } r -= I_SQ;
            if (r < I_SQ) { transpose_item(args.in[17], DM, WcoT, DM, 0, scr, r / 32, r % 32, lane, nullptr, 0); continue; } r -= I_SQ;
            if (r < I_CKV) { transpose_item(args.in[16], 2 * DM, WckvT, DM, 0, scr, r / 64, r % 64, lane, args.in[14], 0); continue; } r -= I_CKV;
            if (r < I_GU) { transpose_item(args.in[19], 2 * DFF, WguT, DM, 0, scr, r / 176, r % 176, lane, args.in[18], 2); continue; } r -= I_GU;
            transpose_item(args.in[20], DM, WdT, DFF, 0, scr, r / 32, r % 32, lane, nullptr, 0);
        }
        for (int m = gw; m < MROWS; m += 4 * NGW) {
            if (m + 3 * NGW < MROWS) row4_to_bf16(x + (size_t)m * DM, XB + (size_t)m * DM, stats + ST_RSTD1 + m, lane, (size_t)NGW * DM, NGW);
            else for (int mm = m; mm < MROWS; mm += NGW) row_to_bf16(x + (size_t)mm * DM, XB + (size_t)mm * DM, stats + ST_RSTD1 + mm, lane);
        }
        for (int m = gw; m < MEMROWS; m += NGW) row_to_bf16(mem + (size_t)m * DM, MEMB + (size_t)m * DM, stats + ST_RSTDM + m, lane);
        const int gt = bx * (NWAVES * 64) + tid, NGT = G * NWAVES * 64;
        for (int i = gt; i < 3 * MROWS; i += NGT) stats[ST_SSQ2 + i] = 0.f;
        for (int i = gt; i < SEQ * 32; i += NGT) {
            const int pos = i >> 5, fi = i & 31;
            const float inv = (float)exp2(-(double)fi * (13.287712379549449 / 32.0));
            const float ang = (float)pos * inv;
            const double a = (double)ang; const double k = rint(a * 0.15915494309189535); const double rr = fma(-k, 6.283185307179586, a) - k * 2.4492935982947064e-16;
            stats[ST_COS + i] = (float)cos_poly(rr); stats[ST_SIN + i] = (float)sin_poly(rr);
        }
        if (gt < 64) {
            const float a = wave_sum(args.in[4][lane] * args.in[5][lane]), b = wave_sum(args.in[6][lane] * args.in[7][lane]);
            if (gt == 0) stats[ST_LAM] = expf(a) - expf(b) + 0.2f;
        }
    }
    SEAM(0);

    if (IN(1)) for (int prb = 0; prb < REP_P1; ++prb) {
        { pg8::Gemm g{XB, WinT, DM, DM, DM}; pg8::StaticOrder S; S.init(MROWS, INC, G, bx);
          pg8::EpiZ E{QKV, GB, stats + ST_RSTD1, stats + ST_COS, stats + ST_SIN};
          pg8::gemm_phase(lds, g, S, E); }
        { pg8::Gemm g{MEMB, WckvT, DM, DM, DM}; pg8::StaticOrder S; S.init(2 * MEMROWS, 2 * DM, G, bx);
          pg8::EpiScaleHalf E{KVX, 2 * DM, stats + ST_RSTDM};
          pg8::gemm_phase<pg8::EpiScaleHalf, false, true, pg8::StaticOrder, true>(lds, g, S, E); }
    }
    SEAM(1);

#ifndef REP_P2
#define REP_P2 1
#endif
#ifndef REP_P6
#define REP_P6 1
#endif
    if (IN(2)) for (int prb = 0; prb < REP_P2; ++prb) {
        const float lam = stats[ST_LAM];
        const float* subln = args.in[8]; const float* relb = args.in[9];
        const int l31 = lane & 31, h = lane >> 5;
#ifndef NO_A
        for (int i0 = bx; i0 < 256; i0 += G) {
#pragma unroll 1
            for (int rep = 0; rep < 2; ++rep) {
                const int i = rep ? 511 - i0 : i0;
                const int qb = 7 - (i >> 6), bh = i & 63, b = bh >> 2, hd = bh & 3;
                const int q0 = qb * 256 + wave * 32, cw = 4 * qb + (wave >> 1);
                const size_t rowb = (size_t)b * SEQ;
                f32x16 O1[4], O2[4];
                bf16_t* yrow = Y + (rowb + q0 + l31) * DM + hd * 128;
                fa::flash_pass_dma<128, 0>(lds, QKV + (rowb + q0) * QKVW + hd * 128, QKVW, QKV + rowb * QKVW + 512 + hd * 128, QKVW, QKV + rowb * QKVW + 1024 + hd * 128, QKVW,
                                           0, 4 * qb + 4, 0, cw + 1, 0.125f * LOG2E, 0, O1);
                fa::store_ot<4>(O1, yrow, h);
                fa::flash_pass_dma<128, 0>(lds, QKV + (rowb + q0) * QKVW + hd * 128 + 64, QKVW, QKV + rowb * QKVW + 512 + hd * 128 + 64, QKVW, QKV + rowb * QKVW + 1024 + hd * 128, QKVW,
                                           0, 4 * qb + 4, 0, cw + 1, 0.125f * LOG2E, 0, O2);
                float ss = 0.f;
#pragma unroll
                for (int d = 0; d < 4; ++d)
#pragma unroll
                    for (int j = 0; j < 4; ++j) { const u32x2 w = *(const u32x2*)(yrow + 32 * d + 8 * j + 4 * h);
                        O1[d][4 * j] = bflo(w.x) - lam * O2[d][4 * j]; O1[d][4 * j + 1] = bfhi(w.x) - lam * O2[d][4 * j + 1];
                        O1[d][4 * j + 2] = bflo(w.y) - lam * O2[d][4 * j + 2]; O1[d][4 * j + 3] = bfhi(w.y) - lam * O2[d][4 * j + 3];
#pragma unroll
                        for (int e = 0; e < 4; ++e) ss += O1[d][4 * j + e] * O1[d][4 * j + e]; }
                ss += __shfl_xor(ss, 32);
                const float rn = __builtin_amdgcn_rsqf(ss * (1.f / 128.f) + EPS) * 0.8f;
#pragma unroll
                for (int d = 0; d < 4; ++d)
#pragma unroll
                    for (int j = 0; j < 4; ++j) { const f32x4 gsub = *(const f32x4*)(subln + 32 * d + 8 * j + 4 * h);
#pragma unroll
                        for (int e = 0; e < 4; ++e) O1[d][4 * j + e] *= rn * gsub[e]; }
                fa::store_ot<4>(O1, yrow, h);
            }
        }
#endif
#ifndef NO_B
        for (int j = bx; j < 1024; j += G) {
            const int qb = j >> 7, bh = j & 127, b = bh >> 3, hd = bh & 7;
            const int c0 = 4 * qb, cw = c0 + (wave >> 1), q0 = qb * 256 + wave * 32;
            const size_t rowb = (size_t)b * SEQ;
            __syncthreads();
            { LAS float* bl = (LAS float*)(lds + fa::BIAS_OFF);
              for (int i = tid; i < 4 * fa::BIAS_COPY_N; i += NWAVES * 64) { const int k = i / fa::BIAS_COPY_N, jj = i - k * fa::BIAS_COPY_N; const int v = jj + k;
                  bl[i] = relb[hd * 513 + min(max(575 - v, -256), 256) + 256] * LOG2E; } }
            f32x16 O[2];
            fa::flash_pass_dma<64, 1>(lds, QKV + (rowb + q0) * QKVW + 1536 + hd * 64, QKVW, QKV + rowb * QKVW + 2048 + hd * 64, QKVW, QKV + rowb * QKVW + 2560 + hd * 64, QKVW,
                                      max(0, c0 - 8), c0 + 4, max(0, cw - 8), cw + 1, 0.125f * LOG2E, q0, O);
            fa::store_ot<2>(O, Y + (rowb + q0 + l31) * DM + 512 + hd * 64, h);
        }
#endif
    }
    SEAM(2);

    if (IN(3)) {
        pg8::Gemm g{Y, WupT, DM, DM, 512}; pg8::StaticOrder S; S.init(MROWS, DM, G, bx); pg8::EpiGateMerged E{T, GB};
        pg8::gemm_phase<pg8::EpiGateMerged, true>(lds, g, S, E);
    }
#ifndef NO_PRE
    if (IN(3)) {
        bf16_t* WKt = (bf16_t*)(ws + WS_OX); bf16_t* VWt = WKt + (size_t)16 * 1024 * 1024;
        int kpre = 256; asm volatile("" : "+s"(kpre));
        { pg8::Gemm g{KVX, WcqT, 2 * DM, DM, kpre}; pg8::PreOrder<0> S{G, bx, KVX, WcqT};
          pg8::EpiScale<false> E{WKt, DM, nullptr, 0.0625f * LOG2E}; pg8::gemm_phase<pg8::EpiScale<false>, false, true, pg8::PreOrder<0>>(lds, g, S, E); }
        { pg8::Gemm g{WcoT, KVX, DM, 2 * DM, kpre}; pg8::PreOrder<1> S{G, bx, KVX, WcoT};
          pg8::EpiScale<false> E{VWt, DM, nullptr, 1.f}; pg8::gemm_phase<pg8::EpiScale<false>, false, true, pg8::PreOrder<1>>(lds, g, S, E); }
    }
#endif
    SEAM(3);

    if (IN(4)) {
        pg8::Gemm g{T, WoutT, DM, DM, DM}; pg8::StaticOrder S; S.init(MROWS, DM, G, bx);
        pg8::EpiResid<true> E{x, nullptr, X1B, stats + ST_SSQ2}; pg8::gemm_phase(lds, g, S, E);
    }
    SEAM(4);

    if (IN(5)) {
        const bf16_t* WKt = (const bf16_t*)(ws + WS_OX);
        pg8::Gemm g{X1B, WKt, DM, DM, DM, (size_t)1024 * 1024 * 2}; pg8::StaticOrder S; S.init(MROWS, DM, G, bx);
        pg8::EpiSoftmax E{QX, stats + ST_SSQ2, (LAS float*)(lds + 131072)}; pg8::gemm_phase(lds, g, S, E);
    }
    SEAM(6);

    if (IN(7)) {
        const bf16_t* VWt = (const bf16_t*)(ws + WS_OX) + (size_t)16 * 1024 * 1024;
        pg8::Gemm g{QX, VWt, DM, DM, DM, (size_t)1024 * 1024 * 2}; pg8::StaticOrder S; S.init(MROWS, DM, G, bx);
        pg8::EpiResid<false> E{nullptr, X1B, X2B, stats + ST_SSQ3}; pg8::gemm_phase(lds, g, S, E);
    }
    SEAM(7);

    if (IN(8)) for (int prb = 0; prb < REP_P8; ++prb) {
        pg8::Gemm g{X2B, WguT, DM, DM, DM}; pg8::StaticOrder S; S.init(MROWS, 2 * DFF, G, bx);
        pg8::EpiSwiGLU E{ACT, stats + ST_SSQ3}; pg8::gemm_phase(lds, g, S, E);
    }
    SEAM(8);

    if (IN(9)) {
        pg8::Gemm g{ACT, WdT, DFF, DFF, DFF}; pg8::StaticOrder S; S.init(MROWS, DM, G, bx);
        pg8::EpiResid<false> E{nullptr, X2B, X1B  , stats + ST_SSQ4}; pg8::gemm_phase(lds, g, S, E);
    }
    SEAM(9);

    if (IN(10)) {
        const float* gf = args.in[21];
        const int gw = bx * NWAVES + wave, NGW = G * NWAVES;
        for (int m0 = gw; m0 < MROWS; m0 += 4 * NGW) {
            u32x2 w[4][4]; float rs[4];
#pragma unroll
            for (int q = 0; q < 4; ++q) { const int m = min(m0 + q * NGW, MROWS - 1); rs[q] = stats[ST_SSQ4 + m];
#pragma unroll
                for (int j = 0; j < 4; ++j) w[q][j] = __builtin_nontemporal_load((const u32x2*)(X1B + (size_t)m * DM) + lane + 64 * j); }
#pragma unroll
            for (int q = 0; q < 4; ++q) { const int m = m0 + q * NGW; if (m < MROWS) { const float r = __builtin_amdgcn_rsqf(rs[q] * (1.f / DM) + EPS);
                f32x4* xr = (f32x4*)(out + (size_t)m * DM) + lane;
#pragma unroll
                for (int j = 0; j < 4; ++j) { const f32x4 gg = *((const f32x4*)gf + lane + 64 * j);
                    __builtin_nontemporal_store((f32x4){bflo(w[q][j].x), bfhi(w[q][j].x), bflo(w[q][j].y), bfhi(w[q][j].y)} * r * gg, &xr[64 * j]); } } }
        }
    }
#undef IN
#undef SEAM
}

extern "C" void kernel_launch(void* const* d_in, const int* in_sizes, int n_in, void* d_out, int out_size, void* d_ws, size_t ws_size, hipStream_t stream) {
    static int grid = 0;
    if (grid == 0) {
        if (n_in != 22 || out_size != MROWS * DM || ws_size < WS_END) { fprintf(stderr, "kernel_launch: unexpected shapes (n_in %d out %d ws %zu)\n", n_in, out_size, ws_size); grid = -1; return; }
        int dev = 0, cus = 0, per_cu = 0;
        hipGetDevice(&dev); hipDeviceGetAttribute(&cus, hipDeviceAttributeMultiprocessorCount, dev);
        if (hipFuncSetAttribute((const void*)mk_fwd, hipFuncAttributeMaxDynamicSharedMemorySize, LDS_BYTES) != hipSuccess) { fprintf(stderr, "kernel_launch: hipFuncSetAttribute failed\n"); grid = -1; return; }
        if (hipOccupancyMaxActiveBlocksPerMultiprocessor(&per_cu, (const void*)mk_fwd, NWAVES * 64, LDS_BYTES) != hipSuccess || per_cu < 1) { per_cu = 1; (void)hipGetLastError(); }
        grid = cus * 1;
        fprintf(stderr, "kernel_launch: grid %d (occupancy query %d per CU)\n", grid, per_cu);
    }
    if (grid < 0) return;
#if ONE_LAUNCH
    if (hipMemsetAsync((char*)d_ws + WS_CTL, 0, XCD_BAR_WORDS * 4, stream) != hipSuccess) { fprintf(stderr, "kernel_launch: memset failed\n"); return; }
#endif
    Args a{};
    for (int i = 0; i < 22; ++i) a.in[i] = (const float*)d_in[i];
    a.out = (float*)d_out; a.ws = (unsigned char*)d_ws;
#if ONE_LAUNCH
    a.ph_lo = 0; a.ph_hi = NPHASE;
    void* kargs[] = {&a};
    hipError_t e = hipLaunchCooperativeKernel((const void*)mk_fwd, dim3(grid), dim3(NWAVES * 64), kargs, LDS_BYTES, stream);
    if (e != hipSuccess) fprintf(stderr, "cooperative launch failed: %s (grid %d)\n", hipGetErrorString(e), grid);
#else
#ifndef PROBE_MASK
#define PROBE_MASK 0
#endif
    for (int p = 0; p < NPHASE; ++p) { a.ph_lo = p; a.ph_hi = p + 1; const int nrep = ((PROBE_MASK >> p) & 1) ? 2 : 1;
        for (int r = 0; r < nrep; ++r) hipLaunchKernelGGL(mk_fwd, dim3(grid), dim3(NWAVES * 64), LDS_BYTES, stream, a); }
#endif
}
```

```cpp
#include <hip/hip_runtime.h>
#include <hip/hip_cooperative_groups.h>
#include <cstdio>
#include <cstdint>
namespace cg = cooperative_groups;

#ifndef ONE_LAUNCH
#define ONE_LAUNCH 1
#endif

#define REP_P0 1
#define REP_P1 1
#define REP_P8 1
#define LAS __attribute__((address_space(3)))
typedef unsigned short bf16_t;
typedef short bf16x8 __attribute__((ext_vector_type(8)));
typedef short s16x4 __attribute__((ext_vector_type(4)));
typedef short v4i16_t __attribute__((ext_vector_type(4)));
typedef float f32x4 __attribute__((ext_vector_type(4)));
typedef float f32x16 __attribute__((ext_vector_type(16)));
typedef unsigned u32x4 __attribute__((ext_vector_type(4)));
typedef unsigned u32x2 __attribute__((ext_vector_type(2)));
typedef float f32x2_t __attribute__((ext_vector_type(2)));
typedef __bf16 bf16x2_t __attribute__((ext_vector_type(2)));

constexpr int BATCH = 16, SEQ = 2048, DM = 1024, MROWS = BATCH * SEQ;
constexpr int NMEM = 256, MEMROWS = BATCH * NMEM;
constexpr int INC = 5120, DFF = 2816, QKVW = 3072, GW = 2048;
constexpr float EPS = 1e-6f;
constexpr float LOG2E = 1.4426950408889634f;

constexpr size_t MiB = 1u << 20;
constexpr size_t WS_CTL = 0;
constexpr size_t WS_STATS = 1 * MiB;
constexpr int ST_RSTD1 = 0, ST_SSQ2 = 32768, ST_SSQ3 = 65536, ST_SSQ4 = 98304, ST_RSTDM = 131072, ST_LAM = 135168,
              ST_COS = 147456, ST_SIN = ST_COS + 65536;
constexpr size_t WS_WIN = 4 * MiB, WS_WUP = 14 * MiB, WS_WOUT = 16 * MiB, WS_WCQ = 18 * MiB, WS_WCKV = 20 * MiB, WS_WCO = 24 * MiB,
                 WS_WGU = 26 * MiB, WS_WD = 37 * MiB;
constexpr size_t WS_KVX = 44 * MiB, WS_MEMB = 60 * MiB;
constexpr size_t WS_XB = 68 * MiB;
constexpr size_t WS_QKV = 132 * MiB;
constexpr size_t WS_T = 132 * MiB, WS_QX = 196 * MiB, WS_OX = 260 * MiB, WS_ACT = 132 * MiB;
constexpr size_t WS_G = 324 * MiB;
constexpr size_t WS_X1B = 324 * MiB, WS_X2B = 388 * MiB;
constexpr size_t WS_END = 452 * MiB;

__device__ __forceinline__ unsigned pk2(float lo, float hi) { f32x2_t v = {lo, hi}; bf16x2_t b = __builtin_convertvector(v, bf16x2_t); return __builtin_bit_cast(unsigned, b); }
__device__ __forceinline__ float bf2f(unsigned short h) { return __builtin_bit_cast(float, (unsigned)h << 16); }
__device__ __forceinline__ float bflo(unsigned w) { return __builtin_bit_cast(float, w << 16); }
__device__ __forceinline__ float bfhi(unsigned w) { return __builtin_bit_cast(float, w & 0xffff0000u); }
__device__ __forceinline__ float fexp2(float x) { return __builtin_amdgcn_exp2f(x); }
__device__ __forceinline__ float frcp(float x) { return __builtin_amdgcn_rcpf(x); }
__device__ __forceinline__ float fsigmoid(float x) { return frcp(1.f + fexp2(-x * LOG2E)); }
__device__ __forceinline__ float wave_sum(float v) {
#pragma unroll
    for (int o = 1; o < 64; o <<= 1) v += __shfl_xor(v, o);
    return v;
}

namespace pg8 {
constexpr int BM = 256, BK = 64, HALF = 128, HTB = HALF * BK * 2, NXCD = 8, WGM = 6;
__host__ __device__ __forceinline__ int lds_byte(int r, int c) { const int st = (r >> 4) * 2 + (c >> 5), rr = r & 15, cc = c & 31, ob = rr * 64 + cc * 2; return st * 1024 + (ob ^ (((ob >> 9) & 1) << 5)); }
__host__ __device__ __forceinline__ void stage_rc(int b, int& R, int& C) { const int st = b / 1024, sb = b % 1024, swz = sb ^ (((sb >> 9) & 1) << 5); R = (st >> 1) * 16 + swz / 64; C = (st & 1) * 32 + (swz % 64) / 2; }
__host__ __device__ __forceinline__ int perm32(int rho) { const int n = rho >> 4, i = rho & 15; return 8 * (i >> 2) + 4 * n + (i & 3); }

struct Unit { int pm, pn; };
struct Gemm { const bf16_t* A; const bf16_t* Bt; int lda, ldb, K; size_t bbatch = 0; };

struct StaticOrder {
    int nM, nN, nwg, G, c, wgm;
    __device__ void init(int M, int N, int G_, int c_, int wgm_ = WGM) { nM = M / BM; nN = N / BM; nwg = nM * nN; G = G_; c = c_; wgm = wgm_; }
    __device__ bool next(int i, Unit& u) const {
        const long L = (long)i * G + c; if (L >= nwg) return false;
        int wgid = (int)L; { const int q = nwg / NXCD, r = nwg % NXCD, xcd = wgid % NXCD, off = wgid / NXCD; wgid = (xcd < r ? xcd * (q + 1) : r * (q + 1) + (xcd - r) * q) + off; }
        const int nig = wgm * nN, gid = wgid / nig, fm = gid * wgm, gsz = (nM - fm) < wgm ? (nM - fm) : wgm;
        u.pm = fm + ((wgid % nig) % gsz); u.pn = (wgid % nig) / gsz; return true;
    }
    __device__ __forceinline__ const char* abase(const Gemm& g, const Unit& u, size_t tA) const { return (const char*)g.A + (size_t)u.pm * tA; }
    __device__ __forceinline__ const char* bbase(const Gemm& g, const Unit& u, size_t tB) const { return (const char*)g.Bt + (size_t)u.pn * tB + (size_t)(u.pm >> 3) * g.bbatch; }
};
template <int mode> struct PreOrder {
    int G, c; const bf16_t* kvx; const bf16_t* w;
    __device__ bool next(int i, Unit& u) const { const int L = i * G + c; if (L >= 256) return false; u.pm = L >> 2; u.pn = L & 3; return true; }
    __device__ __forceinline__ const char* abase(const Gemm&, const Unit& u, size_t) const {
        return mode == 0 ? (const char*)(kvx + (size_t)(u.pm >> 2) * 256 * 2048 + (u.pm & 3) * 256) : (const char*)(w + (size_t)(u.pm & 3) * 256 * 1024 + u.pn * 256); }
    __device__ __forceinline__ const char* bbase(const Gemm&, const Unit& u, size_t) const {
        return mode == 0 ? (const char*)(w + (size_t)u.pn * 256 * 1024 + (u.pm & 3) * 256) : (const char*)(kvx + (size_t)(u.pm >> 2) * 256 * 2048 + 1024 + u.pn * 256); }
};

template <class Epi, bool SPLIT2 = false, bool ALIGN_EPI = true, class Sched = StaticOrder, bool HALF_M = false>
__device__ __forceinline__ void gemm_phase(LAS unsigned char* lds, const Gemm g, const Sched& S, const Epi& E) {
    const int tid = threadIdx.x, wid = __builtin_amdgcn_readfirstlane(tid >> 6), lane = tid & 63, wr = wid >> 2, wc = wid & 3, fr = lane & 15, fq = lane >> 4;
    const int K = g.K, nt = K / BK;
    unsigned voffA[2], voffB[2];
#pragma unroll
    for (int i = 0; i < 2; ++i) { int R, C; stage_rc(tid * 16 + i * 8192, R, C); const int Rb = (R & ~31) + perm32(R & 31);
        voffA[i] = (unsigned)(R * g.lda + C) * 2u; voffB[i] = (unsigned)(Rb * g.ldb + C) * 2u; }
    const size_t kstep = (size_t)(BK * 2);
    const size_t hstepA = HALF_M ? 0 : (size_t)HALF * g.lda * 2, hstepB = (size_t)HALF * g.ldb * 2;
    const size_t tstepA = HALF_M ? (size_t)HALF * g.lda * 2 : 2 * hstepA, tstepB = 2 * hstepB;
    const unsigned ldsw = (unsigned)wid * 1024u;
    const int aoff = lds_byte(wr * 64 + fr, fq * 8), boff = lds_byte(wc * 32 + fr, fq * 8);
#define PG8_SA(b, h) (((b) * 2 + (h)) * HTB)
#define PG8_SB(b, h) ((4 + (b) * 2 + (h)) * HTB)
#define PG8_STAGE(bufoff, gbase, voff) do { _Pragma("unroll") for (int _i = 0; _i < 2; ++_i) \
        __builtin_amdgcn_global_load_lds((const unsigned*)((const char*)(gbase) + (voff)[_i]), (LAS unsigned*)(lds + (bufoff) + ldsw + _i * 8192), 16, 0, 0); } while (0)
#define PG8_LDA(dst, b, h) do { _Pragma("unroll") for (int m = 0; m < 4; ++m) _Pragma("unroll") for (int k = 0; k < 2; ++k) dst[m][k] = *(const LAS bf16x8*)(lds + PG8_SA(b, h) + aoff + m * 2048 + k * 1024); } while (0)
#define PG8_LDB(dst, b, h) do { _Pragma("unroll") for (int n = 0; n < 2; ++n) _Pragma("unroll") for (int k = 0; k < 2; ++k) dst[n][k] = *(const LAS bf16x8*)(lds + PG8_SB(b, h) + boff + n * 2048 + k * 1024); } while (0)
#define PG8_MMA(ai, bj, At, Bt) do { __builtin_amdgcn_s_setprio(1); _Pragma("unroll") for (int m = 0; m < 4; ++m) _Pragma("unroll") for (int n = 0; n < 2; ++n) _Pragma("unroll") for (int k = 0; k < 2; ++k) \
        acc[ai][bj][m][n] = __builtin_amdgcn_mfma_f32_16x16x32_bf16(Bt[n][k], At[m][k], acc[ai][bj][m][n], 0, 0, 0); __builtin_amdgcn_s_setprio(0); } while (0)
#define PG8_WAIT_V(n) asm volatile("s_waitcnt vmcnt(" #n ")" ::: "memory")
#define PG8_WAIT_L(n) asm volatile("s_waitcnt lgkmcnt(" #n ")" ::: "memory")
#define PG8_BAR __builtin_amdgcn_s_barrier()
#define PG8_SCHED __builtin_amdgcn_sched_barrier(0)
    Unit cur, nxt; int ui = 0;
    constexpr int SH = SPLIT2 ? 1 : 0; constexpr size_t SUBSTEP = 1024;
    if (!S.next(0, cur)) return;
    f32x4 acc[2][2][4][2];
#pragma unroll
    for (int a = 0; a < 2; ++a)
#pragma unroll
        for (int b = 0; b < 2; ++b)
#pragma unroll
            for (int m = 0; m < 4; ++m)
#pragma unroll
                for (int n = 0; n < 2; ++n) acc[a][b][m][n] = (f32x4){0.f, 0.f, 0.f, 0.f};
    bf16x8 At[4][2], B0[2][2], B1[2][2];
    const char* cA = S.abase(g, cur, tstepA); const char* cB = S.bbase(g, cur, tstepB);
    PG8_STAGE(PG8_SB(0, 0), cB, voffB); PG8_STAGE(PG8_SB(0, 1), cB + hstepB, voffB); PG8_STAGE(PG8_SA(0, 0), cA, voffA); PG8_STAGE(PG8_SA(0, 1), cA + hstepA, voffA);
    if (wr == 1) PG8_BAR;
    PG8_WAIT_V(2); PG8_BAR;
    PG8_STAGE(PG8_SB(1, 0), cB + kstep, voffB); PG8_STAGE(PG8_SA(1, 0), cA + kstep, voffA); PG8_STAGE(PG8_SB(1, 1), cB + hstepB + kstep, voffB);
    PG8_WAIT_V(6); PG8_BAR;
    for (;;) {
        const bool has_next = S.next((ui + 1) >> SH, nxt);
        const size_t nsub = SPLIT2 ? (size_t)((ui + 1) & 1) * SUBSTEP : 0;
        const char* nA = has_next ? S.abase(g, nxt, tstepA) + nsub : cA; const char* nB = has_next ? S.bbase(g, nxt, tstepB) + nsub : cB;
        for (int t = 0; t < nt; t += 2) {
            const bool last = (t == nt - 2);
            const char* a1 = cA + (size_t)(t + 1) * kstep;
            const char* a2 = last ? nA : cA + (size_t)(t + 2) * kstep; const char* b2 = last ? nB : cB + (size_t)(t + 2) * kstep;
            const char* a3 = a2 + kstep; const char* b3 = b2 + kstep;
            PG8_LDB(B0, 0, 0); PG8_LDB(B1, 0, 1); PG8_SCHED; PG8_LDA(At, 0, 0); PG8_STAGE(PG8_SA(1, 1), a1 + hstepA, voffA);
            PG8_WAIT_V(8); PG8_WAIT_L(0); PG8_BAR; PG8_MMA(0, 0, At, B0); PG8_MMA(0, 1, At, B1); PG8_BAR; PG8_SCHED;
            PG8_LDA(At, 0, 1); PG8_STAGE(PG8_SB(0, 0), b2, voffB); PG8_STAGE(PG8_SB(0, 1), b2 + hstepB, voffB); PG8_STAGE(PG8_SA(0, 0), a2, voffA);
            PG8_WAIT_V(8); PG8_WAIT_L(0); PG8_BAR; if constexpr (!HALF_M) { PG8_MMA(1, 0, At, B0); PG8_MMA(1, 1, At, B1); } PG8_BAR; PG8_SCHED;
            PG8_LDB(B0, 1, 0); PG8_LDB(B1, 1, 1); PG8_SCHED; PG8_LDA(At, 1, 0); PG8_STAGE(PG8_SA(0, 1), a2 + hstepA, voffA);
            PG8_WAIT_V(8); PG8_WAIT_L(0); PG8_BAR; PG8_MMA(0, 0, At, B0); PG8_MMA(0, 1, At, B1); PG8_BAR; PG8_SCHED;
            PG8_LDA(At, 1, 1); PG8_STAGE(PG8_SB(1, 0), b3, voffB); PG8_STAGE(PG8_SB(1, 1), b3 + hstepB, voffB); PG8_STAGE(PG8_SA(1, 0), a3, voffA);
            PG8_WAIT_V(8); PG8_WAIT_L(0); PG8_BAR; if constexpr (!HALF_M) { PG8_MMA(1, 0, At, B0); PG8_MMA(1, 1, At, B1); } PG8_BAR; PG8_SCHED;
        }
        if constexpr (ALIGN_EPI) { if (wr == 0) PG8_BAR; }
        if constexpr (SPLIT2) { if (!(ui & 1)) E.first(acc, cur, wr, wc, fr, fq); else E(acc, cur, wr, wc, fr, fq); }
        else E(acc, cur, wr, wc, fr, fq);
        if (!has_next) break;
#pragma unroll
        for (int a = 0; a < 2; ++a)
#pragma unroll
            for (int b = 0; b < 2; ++b)
#pragma unroll
                for (int m = 0; m < 4; ++m)
#pragma unroll
                    for (int n = 0; n < 2; ++n) acc[a][b][m][n] = (f32x4){0.f, 0.f, 0.f, 0.f};
        cur = nxt; cA = nA; cB = nB; ++ui;
        if constexpr (ALIGN_EPI) { if (wr == 1) PG8_BAR; }
    }
    PG8_WAIT_V(0);
    if constexpr (!ALIGN_EPI) { if (wr == 0) PG8_BAR; }
    PG8_BAR;
#undef PG8_SA
#undef PG8_SB
#undef PG8_STAGE
#undef PG8_LDA
#undef PG8_LDB
#undef PG8_MMA
#undef PG8_WAIT_V
#undef PG8_WAIT_L
#undef PG8_BAR
#undef PG8_SCHED
}

#define EPI_LOAD_ROWSCALE(dst, ptr) float dst[2][4]; { const int _r0 = u.pm * BM + wr * 64 + fr; \
    _Pragma("unroll") for (int _a = 0; _a < 2; ++_a) _Pragma("unroll") for (int _m = 0; _m < 4; ++_m) dst[_a][_m] = (ptr)[_r0 + _a * HALF + _m * 16]; \
    asm volatile("s_waitcnt vmcnt(0)" ::: "memory"); \
    _Pragma("unroll") for (int _a = 0; _a < 2; ++_a) _Pragma("unroll") for (int _m = 0; _m < 4; ++_m) asm volatile("" : "+v"(dst[_a][_m])); }
#define EPI_ROWS_BEGIN const int row0 = u.pm * BM + wr * 64 + fr; const int cb = u.pn * BM + wc * 32 + 8 * fq; \
    _Pragma("unroll") for (int ai = 0; ai < 2; ++ai) _Pragma("unroll") for (int m = 0; m < 4; ++m) { const int row = row0 + ai * HALF + m * 16;

__device__ __forceinline__ u32x4 pack8(f32x4 v0, f32x4 v1) { u32x4 w; w.x = pk2(v0[0], v0[1]); w.y = pk2(v0[2], v0[3]); w.z = pk2(v1[0], v1[1]); w.w = pk2(v1[2], v1[3]); return w; }

struct EpiZ {
    bf16_t* QKV; bf16_t* G; const float* rstd; const float* cosT; const float* sinT;
    __device__ __forceinline__ void operator()(const f32x4 (&acc)[2][2][4][2], const Unit& u, int wr, int wc, int fr, int fq) const {
        EPI_LOAD_ROWSCALE(rsv, rstd)
        EPI_ROWS_BEGIN
            const float rs = rsv[ai][m]; const int pos = row & (SEQ - 1);
#pragma unroll
            for (int bj = 0; bj < 2; ++bj) { const int c = cb + bj * HALF; f32x4 v0 = acc[ai][bj][m][0] * rs, v1 = acc[ai][bj][m][1] * rs;
                if (u.pn < 4) {
                    const int i0 = (c & 63) >> 1;
                    const f32x4 cs = *(const f32x4*)(cosT + pos * 32 + i0), sn = *(const f32x4*)(sinT + pos * 32 + i0);
                    f32x4 r0, r1;
                    r0[0] = v0[0] * cs[0] - v0[1] * sn[0]; r0[1] = v0[1] * cs[0] + v0[0] * sn[0];
                    r0[2] = v0[2] * cs[1] - v0[3] * sn[1]; r0[3] = v0[3] * cs[1] + v0[2] * sn[1];
                    r1[0] = v1[0] * cs[2] - v1[1] * sn[2]; r1[1] = v1[1] * cs[2] + v1[0] * sn[2];
                    r1[2] = v1[2] * cs[3] - v1[3] * sn[3]; r1[3] = v1[3] * cs[3] + v1[2] * sn[3];
                    v0 = r0; v1 = r1;
                }
                if (u.pn < 12) { *(u32x4*)(QKV + (size_t)row * QKVW + c) = pack8(v0, v1); }
                else {
#pragma unroll
                    for (int e = 0; e < 4; ++e) { v0[e] = fsigmoid(v0[e]); v1[e] = fsigmoid(v1[e]); }
                    *(u32x4*)(G + (size_t)row * GW + (c - QKVW)) = pack8(v0, v1);
                }
            }
        }
    }
};

template <bool FROM_SSQ> struct EpiScale {
    bf16_t* O; int ldc; const float* rs; float cs = 1.f;
    __device__ __forceinline__ void operator()(const f32x4 (&acc)[2][2][4][2], const Unit& u, int wr, int wc, int fr, int fq) const {
        EPI_ROWS_BEGIN
            float s = cs; if (rs) { s = rs[row]; if (FROM_SSQ) s = __builtin_amdgcn_rsqf(s * (1.f / DM) + EPS); }
#pragma unroll
            for (int bj = 0; bj < 2; ++bj) { const int c = cb + bj * HALF;
                *(u32x4*)(O + (size_t)row * ldc + c) = pack8(acc[ai][bj][m][0] * s, acc[ai][bj][m][1] * s); }
        }
    }
};


struct EpiScaleHalf {
    bf16_t* O; int ldc; const float* rs;
    __device__ __forceinline__ void operator()(const f32x4 (&acc)[2][2][4][2], const Unit& u, int wr, int wc, int fr, int fq) const {
        const int row0 = u.pm * HALF + wr * 64 + fr; const int cb = u.pn * BM + wc * 32 + 8 * fq;
        float sv[4];
#pragma unroll
        for (int m = 0; m < 4; ++m) sv[m] = rs[row0 + m * 16];
        asm volatile("s_waitcnt vmcnt(0)" ::: "memory");
#pragma unroll
        for (int m = 0; m < 4; ++m) asm volatile("" : "+v"(sv[m]));
#pragma unroll
        for (int m = 0; m < 4; ++m) { const int row = row0 + m * 16; const float s = sv[m];
#pragma unroll
            for (int bj = 0; bj < 2; ++bj) { const int c = cb + bj * HALF;
                *(u32x4*)(O + (size_t)row * ldc + c) = pack8(acc[0][bj][m][0] * s, acc[0][bj][m][1] * s); }
        }
    }
};

struct EpiGateMerged {
    bf16_t* T; const bf16_t* G;
    template <bool SECOND> __device__ __forceinline__ void run(const f32x4 (&acc)[2][2][4][2], const Unit& u, int wr, int wc, int fr, int fq) const {
        const int row0 = u.pm * BM + wr * 64 + fr; const int cb = u.pn * BM + wc * 32 + 8 * fq;
#pragma unroll
        for (int ai = 0; ai < 2; ++ai)
#pragma unroll
        for (int mh = 0; mh < 2; ++mh) {
            u32x4 gv[2][2], tv[2][2];
#pragma unroll
            for (int mm = 0; mm < 2; ++mm)
#pragma unroll
                for (int bj = 0; bj < 2; ++bj) { const int row = row0 + ai * HALF + (2 * mh + mm) * 16, c = cb + bj * HALF;
                    gv[mm][bj] = *(const u32x4*)(G + (size_t)row * GW + (SECOND ? DM : 0) + c);
                    if (SECOND) tv[mm][bj] = *(const u32x4*)(T + (size_t)row * DM + c); }
            asm volatile("s_waitcnt vmcnt(0)" ::: "memory");
#pragma unroll
            for (int mm = 0; mm < 2; ++mm)
#pragma unroll
                for (int bj = 0; bj < 2; ++bj) { asm volatile("" : "+v"(gv[mm][bj])); if (SECOND) asm volatile("" : "+v"(tv[mm][bj])); }
#pragma unroll
            for (int mm = 0; mm < 2; ++mm)
#pragma unroll
                for (int bj = 0; bj < 2; ++bj) { const int m = 2 * mh + mm; const int row = row0 + ai * HALF + m * 16, c = cb + bj * HALF;
                    const u32x4 gw = gv[mm][bj];
                    const f32x4 g0 = {bflo(gw.x), bfhi(gw.x), bflo(gw.y), bfhi(gw.y)}, g1 = {bflo(gw.z), bfhi(gw.z), bflo(gw.w), bfhi(gw.w)};
                    f32x4 v0 = acc[ai][bj][m][0] * g0, v1 = acc[ai][bj][m][1] * g1;
                    if (SECOND) { const u32x4 tw = tv[mm][bj];
                        v0 += (f32x4){bflo(tw.x), bfhi(tw.x), bflo(tw.y), bfhi(tw.y)}; v1 += (f32x4){bflo(tw.z), bfhi(tw.z), bflo(tw.w), bfhi(tw.w)}; }
                    *(u32x4*)(T + (size_t)row * DM + c) = pack8(v0, v1); }
        }
    }
    __device__ __forceinline__ void first(const f32x4 (&acc)[2][2][4][2], const Unit& u, int wr, int wc, int fr, int fq) const { run<false>(acc, u, wr, wc, fr, fq); }
    __device__ __forceinline__ void operator()(const f32x4 (&acc)[2][2][4][2], const Unit& u, int wr, int wc, int fr, int fq) const { run<true>(acc, u, wr, wc, fr, fq); }
};

template <bool XIN_F32> struct EpiResid {
    const float* xin; const bf16_t* xinb; bf16_t* xb; float* ssq;
    __device__ __forceinline__ void operator()(const f32x4 (&acc)[2][2][4][2], const Unit& u, int wr, int wc, int fr, int fq) const {
        const int row0 = u.pm * BM + wr * 64 + fr; const int cb = u.pn * BM + wc * 32 + 8 * fq;
#pragma unroll
        for (int ai = 0; ai < 2; ++ai) {
            f32x4 xv[4][2][2];
#pragma unroll
            for (int m = 0; m < 4; ++m)
#pragma unroll
                for (int bj = 0; bj < 2; ++bj) { const size_t o = (size_t)(row0 + ai * HALF + m * 16) * DM + cb + bj * HALF;
                    if (XIN_F32) { xv[m][bj][0] = *(const f32x4*)(xin + o); xv[m][bj][1] = *(const f32x4*)(xin + o + 4); }
                    else { const u32x4 w = *(const u32x4*)(xinb + o); xv[m][bj][0] = __builtin_bit_cast(f32x4, w); } }
            asm volatile("s_waitcnt vmcnt(0)" ::: "memory");
#pragma unroll
            for (int m = 0; m < 4; ++m)
#pragma unroll
                for (int bj = 0; bj < 2; ++bj) { asm volatile("" : "+v"(xv[m][bj][0])); if (XIN_F32) asm volatile("" : "+v"(xv[m][bj][1])); }
#pragma unroll
            for (int m = 0; m < 4; ++m) { const int row = row0 + ai * HALF + m * 16;
                float ss = 0.f;
#pragma unroll
                for (int bj = 0; bj < 2; ++bj) { const size_t o = (size_t)row * DM + cb + bj * HALF;
                    f32x4 v0, v1;
                    if (XIN_F32) { v0 = xv[m][bj][0]; v1 = xv[m][bj][1]; }
                    else { const u32x4 w = __builtin_bit_cast(u32x4, xv[m][bj][0]); v0 = (f32x4){bflo(w.x), bfhi(w.x), bflo(w.y), bfhi(w.y)}; v1 = (f32x4){bflo(w.z), bfhi(w.z), bflo(w.w), bfhi(w.w)}; }
                    v0 += acc[ai][bj][m][0]; v1 += acc[ai][bj][m][1];
                    *(u32x4*)(xb + o) = pack8(v0, v1);
                    ss += (v0[0] * v0[0] + v0[1] * v0[1]) + (v0[2] * v0[2] + v0[3] * v0[3]) + (v1[0] * v1[0] + v1[1] * v1[1]) + (v1[2] * v1[2] + v1[3] * v1[3]); }
                ss += __shfl_xor(ss, 16); ss += __shfl_xor(ss, 32);
                if (fq == 0) unsafeAtomicAdd(ssq + row, ss);
            }
        }
    }
};


struct EpiSoftmax {
    bf16_t* P; const float* ssq; LAS float* red;
    __device__ __forceinline__ void operator()(f32x4 (&acc)[2][2][4][2], const Unit& u, int wr, int wc, int fr, int fq) const {
        float mrow[2][4];
        EPI_LOAD_ROWSCALE(ssv, ssq)
        { EPI_ROWS_BEGIN
            (void)row; const float s = __builtin_amdgcn_rsqf(ssv[ai][m] * (1.f / DM) + EPS);
            float mx = -1e30f;
#pragma unroll
            for (int bj = 0; bj < 2; ++bj)
#pragma unroll
                for (int n = 0; n < 2; ++n) { acc[ai][bj][m][n] *= s;
#pragma unroll
                    for (int e = 0; e < 4; ++e) mx = fmaxf(mx, acc[ai][bj][m][n][e]); }
            mx = fmaxf(mx, __shfl_xor(mx, 16)); mx = fmaxf(mx, __shfl_xor(mx, 32));
            mrow[ai][m] = mx;
            if (fq == 0) red[(ai * HALF + wr * 64 + m * 16 + fr) * 4 + wc] = mx;
        } }
        __syncthreads();
        { EPI_ROWS_BEGIN
            (void)row;
            const f32x4 r4 = *(const LAS f32x4*)(red + (ai * HALF + wr * 64 + m * 16 + fr) * 4);
            const float mx = fmaxf(fmaxf(r4[0], r4[1]), fmaxf(r4[2], r4[3]));
            float sum = 0.f;
#pragma unroll
            for (int bj = 0; bj < 2; ++bj)
#pragma unroll
                for (int n = 0; n < 2; ++n)
#pragma unroll
                    for (int e = 0; e < 4; ++e) { const float p = fexp2(acc[ai][bj][m][n][e] - mx); acc[ai][bj][m][n][e] = p; sum += p; }
            sum += __shfl_xor(sum, 16); sum += __shfl_xor(sum, 32);
            mrow[ai][m] = sum;
            if (fq == 0) red[1024 + (ai * HALF + wr * 64 + m * 16 + fr) * 4 + wc] = sum;
        } }
        __syncthreads();
        { EPI_ROWS_BEGIN
            const f32x4 r4 = *(const LAS f32x4*)(red + 1024 + (ai * HALF + wr * 64 + m * 16 + fr) * 4);
            const float inv = frcp((r4[0] + r4[1]) + (r4[2] + r4[3]));
#pragma unroll
            for (int bj = 0; bj < 2; ++bj) { const int c = cb + bj * HALF;
                *(u32x4*)(P + (size_t)row * DM + c) = pack8(acc[ai][bj][m][0] * inv, acc[ai][bj][m][1] * inv); }
        } }
    }
};

struct EpiSwiGLU {
    bf16_t* ACT; const float* ssq;
    __device__ __forceinline__ void operator()(const f32x4 (&acc)[2][2][4][2], const Unit& u, int wr, int wc, int fr, int fq) const {
        EPI_LOAD_ROWSCALE(ssv, ssq)
        EPI_ROWS_BEGIN
            (void)row; const float s = __builtin_amdgcn_rsqf(ssv[ai][m] * (1.f / DM) + EPS);
#pragma unroll
            for (int bj = 0; bj < 2; ++bj) { const int c = cb + bj * HALF;
                const f32x4 v0 = acc[ai][bj][m][0] * s, v1 = acc[ai][bj][m][1] * s;
                const float a0 = v0[0] * fsigmoid(v0[0]) * v0[1], a1 = v0[2] * fsigmoid(v0[2]) * v0[3];
                const float a2 = v1[0] * fsigmoid(v1[0]) * v1[1], a3 = v1[2] * fsigmoid(v1[2]) * v1[3];
                u32x2 w; w.x = pk2(a0, a1); w.y = pk2(a2, a3);
                *(u32x2*)(ACT + (size_t)row * DFF + (c >> 1)) = w; }
        }
    }
};
}

namespace fa {
constexpr int BIAS_OFF = 98304, BIAS_COPY_N = 644, BIAS_COPY_BYTES = BIAS_COPY_N * 4;
#define MFMA32(a, b, c) __builtin_amdgcn_mfma_f32_32x32x16_bf16((a), (b), (c), 0, 0, 0)
__device__ __forceinline__ s16x4 vtr(LAS const unsigned char* p) { return __builtin_bit_cast(s16x4, __builtin_amdgcn_ds_read_tr16_b64_v4i16((LAS v4i16_t*)p)); }

template <int DQK, int DV, int MODE, bool QREG>
__device__ __forceinline__ void flash_pass(LAS unsigned char* lds, const bf16_t* Qw, int ldq, const bf16_t* Kb, int ldk, const bf16_t* Vb, int ldv,
                                           int t_lo, int t_hi, int w_lo, int w_hi, float csc, int qpos_w, f32x16 (&O)[DV / 32]) {
    constexpr int KP2 = (DQK + 8) * 2, VP2 = (DV + 32) * 2;
    constexpr int VOFF = 64 * KP2, BUFB = VOFF + 64 * VP2;
    static_assert(2 * BUFB <= BIAS_OFF, "stage buffers below the bias table");
    constexpr int KCH = DQK / 8, KN = 64 * KCH / 512, VCH = DV / 8, VN = 64 * VCH / 512;
    const int tid = threadIdx.x, lane = tid & 63, l31 = lane & 31, h = lane >> 5;
    const LAS float* bl = (const LAS float*)(lds + BIAS_OFF);
    bf16x8 Qf[QREG ? DQK / 16 : 1];
    const bf16_t* qbase = Qw + (size_t)l31 * ldq + h * 8;
    if (QREG) {
#pragma unroll
        for (int ks = 0; ks < DQK / 16; ++ks) Qf[ks] = *(const bf16x8*)(qbase + ks * 16);
    }
#pragma unroll
    for (int d = 0; d < DV / 32; ++d)
#pragma unroll
        for (int r = 0; r < 16; ++r) O[d][r] = 0.f;
    float mused = -1e30f, lsum = 0.f;
    u32x4 kreg[KN], vreg[VN];
#define FA_LOAD(t) do { \
        _Pragma("unroll") for (int i = 0; i < KN; ++i) { const int cid = tid + i * 512, r = cid / KCH, cc = cid % KCH; kreg[i] = *(const u32x4*)(Kb + (size_t)((t) * 64 + r) * ldk + cc * 8); } \
        _Pragma("unroll") for (int i = 0; i < VN; ++i) { const int cid = tid + i * 512, r = cid / VCH, cc = cid % VCH; vreg[i] = *(const u32x4*)(Vb + (size_t)((t) * 64 + r) * ldv + cc * 8); } } while (0)
#define FA_STORE(b) do { LAS unsigned char* _kb = lds + (b) * BUFB; \
        _Pragma("unroll") for (int i = 0; i < KN; ++i) { const int cid = tid + i * 512, r = cid / KCH, cc = cid % KCH; *(LAS u32x4*)(_kb + r * KP2 + cc * 16) = kreg[i]; } \
        _Pragma("unroll") for (int i = 0; i < VN; ++i) { const int cid = tid + i * 512, r = cid / VCH, cc = cid % VCH; *(LAS u32x4*)(_kb + VOFF + r * VP2 + cc * 16) = vreg[i]; } } while (0)
    FA_LOAD(t_lo);
    const int q4 = (lane & 15) >> 2, p4 = lane & 3, g16 = (lane >> 4) & 1;
    const int kp_off = l31 * KP2 + h * 16;
    const int vp_off = VOFF + (4 * h + q4) * VP2 + (16 * g16 + 4 * p4) * 2;
    FA_STORE(0);
    if (t_lo + 1 < t_hi) FA_LOAD(t_lo + 1);
    __syncthreads();
    for (int t = t_lo; t < t_hi; ++t) {
        const int cur = (t - t_lo) & 1;
        if (t + 1 < t_hi) { FA_STORE(cur ^ 1); if (t + 2 < t_hi) FA_LOAD(t + 2); }
        if (t >= w_lo && t < w_hi) {
            const LAS unsigned char* kp = lds + cur * BUFB + kp_off;
            const LAS unsigned char* vp = lds + cur * BUFB + vp_off;
            f32x16 s0, s1;
#pragma unroll
            for (int r = 0; r < 16; ++r) { s0[r] = 0.f; s1[r] = 0.f; }
            const bf16_t* qp = qbase;
            if (!QREG) asm volatile("" : "+v"(qp));
#pragma unroll
            for (int ks = 0; ks < DQK / 16; ++ks) {
                const bf16x8 a0 = *(const LAS bf16x8*)(kp + ks * 32);
                const bf16x8 a1 = *(const LAS bf16x8*)(kp + 32 * KP2 + ks * 32);
                const bf16x8 qf = QREG ? Qf[ks] : *(const bf16x8*)(qp + ks * 16);
                s0 = MFMA32(a0, qf, s0); s1 = MFMA32(a1, qf, s1);
            }
            float mx;
            if (MODE == 1) {
                const int rel0 = qpos_w + l31 - (t * 64 + 4 * h);
                if (qpos_w - (t * 64 + 63) >= 256) { const float bc = bl[512];
#pragma unroll
                    for (int r = 0; r < 16; ++r) { s0[r] = s0[r] * csc + bc; s1[r] = s1[r] * csc + bc; }
                } else {
#pragma unroll
                    for (int r = 0; r < 16; ++r) {
                        int i0 = rel0 - 8 * (r >> 2) - (r & 3); int i1 = i0 - 32;
                        i0 = min(max(i0, -256), 256) + 256; i1 = min(max(i1, -256), 256) + 256;
                        s0[r] = s0[r] * csc + bl[i0]; s1[r] = s1[r] * csc + bl[i1]; }
                }
                mx = fmaxf(s0[0], s1[0]);
#pragma unroll
                for (int r = 1; r < 16; ++r) mx = fmaxf(mx, fmaxf(s0[r], s1[r]));
            } else {
                mx = fmaxf(s0[0], s1[0]);
#pragma unroll
                for (int r = 1; r < 16; ++r) mx = fmaxf(mx, fmaxf(s0[r], s1[r]));
                mx *= csc;
            }
            mx = fmaxf(mx, __shfl_xor(mx, 32));
            if (__any(mx > mused + 8.f)) {
                const float mn = fmaxf(mused, mx), alpha = fexp2(mused - mn); mused = mn; lsum *= alpha;
#pragma unroll
                for (int d = 0; d < DV / 32; ++d)
#pragma unroll
                    for (int r = 0; r < 16; ++r) O[d][r] *= alpha;
            }
            float rs = 0.f;
            if (MODE == 1) {
#pragma unroll
                for (int r = 0; r < 16; ++r) { s0[r] = fexp2(s0[r] - mused); s1[r] = fexp2(s1[r] - mused); rs += s0[r] + s1[r]; }
            } else {
                const float nm = -mused;
#pragma unroll
                for (int r = 0; r < 16; ++r) { s0[r] = fexp2(__builtin_fmaf(s0[r], csc, nm)); s1[r] = fexp2(__builtin_fmaf(s1[r], csc, nm)); rs += s0[r] + s1[r]; }
            }
            lsum += rs;
            bf16x8 pb[4];
#pragma unroll
            for (int sp = 0; sp < 2; ++sp) {
                u32x4 w0, w1;
                w0.x = pk2(s0[8 * sp + 0], s0[8 * sp + 1]); w0.y = pk2(s0[8 * sp + 2], s0[8 * sp + 3]); w0.z = pk2(s0[8 * sp + 4], s0[8 * sp + 5]); w0.w = pk2(s0[8 * sp + 6], s0[8 * sp + 7]);
                w1.x = pk2(s1[8 * sp + 0], s1[8 * sp + 1]); w1.y = pk2(s1[8 * sp + 2], s1[8 * sp + 3]); w1.z = pk2(s1[8 * sp + 4], s1[8 * sp + 5]); w1.w = pk2(s1[8 * sp + 6], s1[8 * sp + 7]);
                pb[sp] = __builtin_bit_cast(bf16x8, w0); pb[2 + sp] = __builtin_bit_cast(bf16x8, w1);
            }
#pragma unroll
            for (int ks = 0; ks < 4; ++ks) {
#pragma unroll
                for (int d = 0; d < DV / 32; ++d) {
                    const s16x4 r0 = vtr(vp + (16 * ks) * VP2 + d * 64);
                    const s16x4 r1 = vtr(vp + (16 * ks + 8) * VP2 + d * 64);
                    const bf16x8 vf = {r0[0], r0[1], r0[2], r0[3], r1[0], r1[1], r1[2], r1[3]};
                    O[d] = MFMA32(vf, pb[ks], O[d]);
                }
            }
        }
        __syncthreads();
    }
#undef FA_LOAD
#undef FA_STORE
    lsum += __shfl_xor(lsum, 32);
    const float inv = 1.f / lsum;
#pragma unroll
    for (int d = 0; d < DV / 32; ++d)
#pragma unroll
        for (int r = 0; r < 16; ++r) O[d][r] *= inv;
}


template <int DV, int MODE>
__device__ __forceinline__ void flash_pass_dma(LAS unsigned char* lds, const bf16_t* Qw, int ldq, const bf16_t* Kb, int ldk, const bf16_t* Vb, int ldv,
                                               int t_lo, int t_hi, int w_lo, int w_hi, float csc, int qpos_w, f32x16 (&O)[DV / 32]) {
    constexpr int KBYTES = 8192, VROW = DV * 2, BUF = KBYTES + 64 * VROW, VOPS = DV / 64, OPS = 1 + VOPS;
    static_assert(4 * BUF <= BIAS_OFF, "ring below the bias table");
    const int tid = threadIdx.x, lane = tid & 63, l31 = lane & 31, h = lane >> 5, wave = __builtin_amdgcn_readfirstlane(tid >> 6);
    const LAS float* bl = (const LAS float*)(lds + BIAS_OFF);
    bf16x8 Qf[4];
    const bf16_t* qbase = Qw + (size_t)l31 * ldq + h * 8;
#pragma unroll
    for (int ks = 0; ks < 4; ++ks) Qf[ks] = *(const bf16x8*)(qbase + ks * 16);
#pragma unroll
    for (int d = 0; d < DV / 32; ++d)
#pragma unroll
        for (int r = 0; r < 16; ++r) O[d][r] = 0.f;
    float mused = -1e30f, lsum = 0.f;
    unsigned koff, voff[VOPS];
    { const int r = 8 * wave + (lane >> 3), p = lane & 7, c = p ^ ((r >> 1) & 7); koff = (unsigned)(r * ldk + c * 8); }
    if (DV == 128) {
#pragma unroll
        for (int i = 0; i < VOPS; ++i) { const int j = wave * 2 + i, r = 4 * j + (lane >> 4), p = lane & 15, c = p ^ ((r & 3) << 2); voff[i] = (unsigned)(r * ldv + c * 8); }
    } else { const int r = 8 * wave + (lane >> 3), p = lane & 7, c = p ^ (((r >> 1) & 1) << 2); voff[0] = (unsigned)(r * ldv + c * 8); }
#define FD_ISSUE(t, b) do { \
        __builtin_amdgcn_global_load_lds((const unsigned*)(Kb + (size_t)(t) * 64 * ldk + koff), (LAS unsigned*)(lds + (b) * BUF + wave * 1024), 16, 0, 0); \
        _Pragma("unroll") for (int i = 0; i < VOPS; ++i) __builtin_amdgcn_global_load_lds((const unsigned*)(Vb + (size_t)(t) * 64 * ldv + voff[i]), (LAS unsigned*)(lds + (b) * BUF + KBYTES + (wave * VOPS + i) * 1024), 16, 0, 0); } while (0)
    asm volatile("s_waitcnt vmcnt(0)" ::: "memory");
#pragma unroll
    for (int ks = 0; ks < 4; ++ks) asm volatile("" : "+v"(Qf[ks]));
    __builtin_amdgcn_s_barrier();
    asm volatile("" ::: "memory");
    FD_ISSUE(t_lo, 0);
    if (t_lo + 1 < t_hi) FD_ISSUE(t_lo + 1, 1);
    if (t_lo + 2 < t_hi) FD_ISSUE(t_lo + 2, 2);
    const int q4 = (lane & 15) >> 2, p4 = lane & 3, g16 = (lane >> 4) & 1;
    const int yk = (h ^ ((l31 >> 1) & 7)) << 4;
    const int kp_off = l31 * 128;
    const int vp_off = KBYTES + (4 * h + q4) * VROW + g16 * 32 + p4 * 8;
    const int vx = (DV == 128) ? (q4 * 64) : (((q4 >> 1) & 1) * 64);
#pragma unroll 1
    for (int t = t_lo; t < t_hi; ++t) {
        const int rem = t_hi - 1 - t;
        if (rem >= 2) { if (OPS == 3) asm volatile("s_waitcnt vmcnt(6)" ::: "memory"); else asm volatile("s_waitcnt vmcnt(4)" ::: "memory"); }
        else if (rem == 1) { if (OPS == 3) asm volatile("s_waitcnt vmcnt(3)" ::: "memory"); else asm volatile("s_waitcnt vmcnt(2)" ::: "memory"); }
        else asm volatile("s_waitcnt vmcnt(0)" ::: "memory");
        asm volatile("s_waitcnt lgkmcnt(0)" ::: "memory");
        __builtin_amdgcn_s_barrier();
        asm volatile("" ::: "memory");
        if (t + 3 < t_hi) FD_ISSUE(t + 3, (t + 3 - t_lo) & 3);
        if (t >= w_lo && t < w_hi) {
            const LAS unsigned char* bufp = lds + ((t - t_lo) & 3) * BUF;
            const LAS unsigned char* kp = bufp + kp_off;
            const LAS unsigned char* vp = bufp + vp_off;
            f32x16 s0, s1;
#pragma unroll
            for (int r = 0; r < 16; ++r) { s0[r] = 0.f; s1[r] = 0.f; }
#pragma unroll
            for (int ks = 0; ks < 4; ++ks) {
                const bf16x8 a0 = *(const LAS bf16x8*)(kp + ((ks * 32) ^ yk));
                const bf16x8 a1 = *(const LAS bf16x8*)(kp + 32 * 128 + ((ks * 32) ^ yk));
                s0 = MFMA32(a0, Qf[ks], s0); s1 = MFMA32(a1, Qf[ks], s1);
            }
            float mx;
            if (MODE == 1) {
                const int V00 = 575 - (qpos_w + l31 - (t * 64 + 4 * h));
                const LAS unsigned char* bp = (const LAS unsigned char*)bl + (V00 & 3) * BIAS_COPY_BYTES + (V00 & ~3) * 4;
#pragma unroll
                for (int j = 0; j < 4; ++j) {
                    const f32x4 b0 = *(const LAS f32x4*)(bp + (8 * j) * 4), b1 = *(const LAS f32x4*)(bp + (32 + 8 * j) * 4);
#pragma unroll
                    for (int i = 0; i < 4; ++i) { s0[4 * j + i] = s0[4 * j + i] * csc + b0[i]; s1[4 * j + i] = s1[4 * j + i] * csc + b1[i]; }
                }
                mx = fmaxf(s0[0], s1[0]);
#pragma unroll
                for (int r = 1; r < 16; ++r) mx = fmaxf(mx, fmaxf(s0[r], s1[r]));
            } else {
                mx = fmaxf(s0[0], s1[0]);
#pragma unroll
                for (int r = 1; r < 16; ++r) mx = fmaxf(mx, fmaxf(s0[r], s1[r]));
                mx *= csc;
            }
            mx = fmaxf(mx, __shfl_xor(mx, 32));
            if (__any(mx > mused + 8.f)) {
                const float mn = fmaxf(mused, mx), alpha = fexp2(mused - mn); mused = mn; lsum *= alpha;
#pragma unroll
                for (int d = 0; d < DV / 32; ++d)
#pragma unroll
                    for (int r = 0; r < 16; ++r) O[d][r] *= alpha;
            }
            float rs = 0.f;
            if (MODE == 1) {
#pragma unroll
                for (int r = 0; r < 16; ++r) { s0[r] = fexp2(s0[r] - mused); s1[r] = fexp2(s1[r] - mused); rs += s0[r] + s1[r]; }
            } else {
                const float nm = -mused;
#pragma unroll
                for (int r = 0; r < 16; ++r) { s0[r] = fexp2(__builtin_fmaf(s0[r], csc, nm)); s1[r] = fexp2(__builtin_fmaf(s1[r], csc, nm)); rs += s0[r] + s1[r]; }
            }
            lsum += rs;
            bf16x8 pb[4];
#pragma unroll
            for (int sp = 0; sp < 2; ++sp) {
                u32x4 w0, w1;
                w0.x = pk2(s0[8 * sp + 0], s0[8 * sp + 1]); w0.y = pk2(s0[8 * sp + 2], s0[8 * sp + 3]); w0.z = pk2(s0[8 * sp + 4], s0[8 * sp + 5]); w0.w = pk2(s0[8 * sp + 6], s0[8 * sp + 7]);
                w1.x = pk2(s1[8 * sp + 0], s1[8 * sp + 1]); w1.y = pk2(s1[8 * sp + 2], s1[8 * sp + 3]); w1.z = pk2(s1[8 * sp + 4], s1[8 * sp + 5]); w1.w = pk2(s1[8 * sp + 6], s1[8 * sp + 7]);
                pb[sp] = __builtin_bit_cast(bf16x8, w0); pb[2 + sp] = __builtin_bit_cast(bf16x8, w1);
            }
#pragma unroll
            for (int ks = 0; ks < 4; ++ks) {
#pragma unroll
                for (int d = 0; d < DV / 32; ++d) {
                    const s16x4 r0 = vtr(vp + (16 * ks) * VROW + ((d * 64) ^ vx));
                    const s16x4 r1 = vtr(vp + (16 * ks + 8) * VROW + ((d * 64) ^ vx));
                    const bf16x8 vf = {r0[0], r0[1], r0[2], r0[3], r1[0], r1[1], r1[2], r1[3]};
                    O[d] = MFMA32(vf, pb[ks], O[d]);
                }
            }
        }
    }
#undef FD_ISSUE
    lsum += __shfl_xor(lsum, 32);
    const float inv = 1.f / lsum;
#pragma unroll
    for (int d = 0; d < DV / 32; ++d)
#pragma unroll
        for (int r = 0; r < 16; ++r) O[d][r] *= inv;
}


__device__ __forceinline__ void cross_pass(LAS unsigned char* lds, const bf16_t* Qw, const bf16_t* Kb, const bf16_t* Vb, float csc, f32x16 (&O)[4]) {
    constexpr int LDK = 2048, KBYTES = 32768, BUF = 49152;
    const int tid = threadIdx.x, lane = tid & 63, l31 = lane & 31, h = lane >> 5, wave = __builtin_amdgcn_readfirstlane(tid >> 6);
    bf16x8 Qf[16];
    const bf16_t* qbase = Qw + (size_t)l31 * DM + h * 8;
#pragma unroll
    for (int ks = 0; ks < 16; ++ks) Qf[ks] = *(const bf16x8*)(qbase + ks * 16);
#pragma unroll
    for (int d = 0; d < 4; ++d)
#pragma unroll
        for (int r = 0; r < 16; ++r) O[d][r] = 0.f;
    float mused = -1e30f, lsum = 0.f;
    unsigned koff[4], voff[2];
#pragma unroll
    for (int i = 0; i < 4; ++i) { const int j = wave * 4 + i, r = 2 * j + (lane >> 5), p = lane & 31, c = p ^ (r & 31); koff[i] = (unsigned)(r * LDK + c * 8); }
#pragma unroll
    for (int i = 0; i < 2; ++i) { const int j = wave * 2 + i, r = 4 * j + (lane >> 4), p = lane & 15, c = p ^ ((r & 3) << 2); voff[i] = (unsigned)(r * LDK + c * 8); }
#define CX_ISSUE(t, b) do { \
        _Pragma("unroll") for (int i = 0; i < 4; ++i) __builtin_amdgcn_global_load_lds((const unsigned*)(Kb + (size_t)(t) * 64 * LDK + koff[i]), (LAS unsigned*)(lds + (b) * BUF + (wave * 4 + i) * 1024), 16, 0, 0); \
        _Pragma("unroll") for (int i = 0; i < 2; ++i) __builtin_amdgcn_global_load_lds((const unsigned*)(Vb + (size_t)(t) * 64 * LDK + voff[i]), (LAS unsigned*)(lds + (b) * BUF + KBYTES + (wave * 2 + i) * 1024), 16, 0, 0); } while (0)
    asm volatile("s_waitcnt vmcnt(0)" ::: "memory");
#pragma unroll
    for (int ks = 0; ks < 16; ++ks) asm volatile("" : "+v"(Qf[ks]));
    __builtin_amdgcn_s_barrier();
    asm volatile("" ::: "memory");
    CX_ISSUE(0, 0); CX_ISSUE(1, 1);
    const int q4 = (lane & 15) >> 2, p4 = lane & 3, g16 = (lane >> 4) & 1;
    const int yy = (h ^ l31) << 4;
    const int kp_off = l31 * 512;
    const int vp_off = KBYTES + (4 * h + q4) * 256 + g16 * 32 + p4 * 8;
    const int q64 = q4 * 64;
#pragma unroll 1
    for (int t = 0; t < 4; ++t) {
        if (t < 3) asm volatile("s_waitcnt vmcnt(6)" ::: "memory"); else asm volatile("s_waitcnt vmcnt(0)" ::: "memory");
        __builtin_amdgcn_s_barrier();
        asm volatile("" ::: "memory");
        const LAS unsigned char* kp = lds + (t & 1) * BUF + kp_off;
        const LAS unsigned char* vp = lds + (t & 1) * BUF + vp_off;
        f32x16 s0, s1;
#pragma unroll
        for (int r = 0; r < 16; ++r) { s0[r] = 0.f; s1[r] = 0.f; }
#pragma unroll
        for (int ks = 0; ks < 16; ++ks) {
            const bf16x8 a0 = *(const LAS bf16x8*)(kp + ((ks * 32) ^ yy));
            const bf16x8 a1 = *(const LAS bf16x8*)(kp + 32 * 512 + ((ks * 32) ^ yy));
            const bf16x8 qf = Qf[ks];
            s0 = MFMA32(a0, qf, s0); s1 = MFMA32(a1, qf, s1);
        }
        float mx = fmaxf(s0[0], s1[0]);
#pragma unroll
        for (int r = 1; r < 16; ++r) mx = fmaxf(mx, fmaxf(s0[r], s1[r]));
        mx *= csc;
        mx = fmaxf(mx, __shfl_xor(mx, 32));
        if (__any(mx > mused + 8.f)) {
            const float mn = fmaxf(mused, mx), alpha = fexp2(mused - mn); mused = mn; lsum *= alpha;
#pragma unroll
            for (int d = 0; d < 4; ++d)
#pragma unroll
                for (int r = 0; r < 16; ++r) O[d][r] *= alpha;
        }
        float rs = 0.f; const float nm = -mused;
#pragma unroll
        for (int r = 0; r < 16; ++r) { s0[r] = fexp2(__builtin_fmaf(s0[r], csc, nm)); s1[r] = fexp2(__builtin_fmaf(s1[r], csc, nm)); rs += s0[r] + s1[r]; }
        lsum += rs;
        bf16x8 pb[4];
#pragma unroll
        for (int sp = 0; sp < 2; ++sp) {
            u32x4 w0, w1;
            w0.x = pk2(s0[8 * sp + 0], s0[8 * sp + 1]); w0.y = pk2(s0[8 * sp + 2], s0[8 * sp + 3]); w0.z = pk2(s0[8 * sp + 4], s0[8 * sp + 5]); w0.w = pk2(s0[8 * sp + 6], s0[8 * sp + 7]);
            w1.x = pk2(s1[8 * sp + 0], s1[8 * sp + 1]); w1.y = pk2(s1[8 * sp + 2], s1[8 * sp + 3]); w1.z = pk2(s1[8 * sp + 4], s1[8 * sp + 5]); w1.w = pk2(s1[8 * sp + 6], s1[8 * sp + 7]);
            pb[sp] = __builtin_bit_cast(bf16x8, w0); pb[2 + sp] = __builtin_bit_cast(bf16x8, w1);
        }
#pragma unroll
        for (int ks = 0; ks < 4; ++ks) {
#pragma unroll
            for (int d = 0; d < 4; ++d) {
                const s16x4 r0 = vtr(vp + (16 * ks) * 256 + ((d * 64) ^ q64));
                const s16x4 r1 = vtr(vp + (16 * ks + 8) * 256 + ((d * 64) ^ q64));
                const bf16x8 vf = {r0[0], r0[1], r0[2], r0[3], r1[0], r1[1], r1[2], r1[3]};
                O[d] = MFMA32(vf, pb[ks], O[d]);
            }
        }
        if (t + 2 < 4) {
            asm volatile("s_waitcnt lgkmcnt(0)" ::: "memory");
            __builtin_amdgcn_s_barrier();
            asm volatile("" ::: "memory");
            CX_ISSUE(t + 2, t & 1);
        }
    }
#undef CX_ISSUE
    lsum += __shfl_xor(lsum, 32);
    const float inv = 1.f / lsum;
#pragma unroll
    for (int d = 0; d < 4; ++d)
#pragma unroll
        for (int r = 0; r < 16; ++r) O[d][r] *= inv;
}


__device__ __forceinline__ void cross_unit(LAS unsigned char* lds, const bf16_t* Qw, const bf16_t* Kb, const bf16_t* Vb, float csc, bf16_t* orow  ) {
    constexpr int LDK = 2048, TB = 32768;
    const int tid = threadIdx.x, lane = tid & 63, l31 = lane & 31, h = lane >> 5, wave = __builtin_amdgcn_readfirstlane(tid >> 6);
    bf16x8 Qf[16];
    const bf16_t* qbase = Qw + (size_t)l31 * DM + h * 8;
#pragma unroll
    for (int ks = 0; ks < 16; ++ks) Qf[ks] = *(const bf16x8*)(qbase + ks * 16);
    unsigned koff[4], voff[4];
#pragma unroll
    for (int i = 0; i < 4; ++i) { const int j = wave * 4 + i, r = 2 * j + (lane >> 5), p = lane & 31; koff[i] = (unsigned)(r * LDK + (p ^ (r & 31)) * 8); voff[i] = (unsigned)(r * LDK + (p ^ ((r & 3) << 2)) * 8); }
    asm volatile("s_waitcnt vmcnt(0)" ::: "memory");
#pragma unroll
    for (int ks = 0; ks < 16; ++ks) asm volatile("" : "+v"(Qf[ks]));
    asm volatile("s_waitcnt lgkmcnt(0)" ::: "memory");
    __builtin_amdgcn_s_barrier();
    asm volatile("" ::: "memory");
#pragma unroll
    for (int t = 0; t < 4; ++t)
#pragma unroll
        for (int i = 0; i < 4; ++i) __builtin_amdgcn_global_load_lds((const unsigned*)(Kb + (size_t)t * 64 * LDK + koff[i]), (LAS unsigned*)(lds + t * TB + (wave * 4 + i) * 1024), 16, 0, 0);
    asm volatile("s_waitcnt vmcnt(0)" ::: "memory");
    __builtin_amdgcn_s_barrier();
    asm volatile("" ::: "memory");
    const int yy = (h ^ l31) << 4;
    f32x16 S[4][2];
#pragma unroll
    for (int t = 0; t < 4; ++t) {
        const LAS unsigned char* kp = lds + t * TB + l31 * 512;
#pragma unroll
        for (int r = 0; r < 16; ++r) { S[t][0][r] = 0.f; S[t][1][r] = 0.f; }
#pragma unroll
        for (int ks = 0; ks < 16; ++ks) {
            const bf16x8 a0 = *(const LAS bf16x8*)(kp + ((ks * 32) ^ yy));
            const bf16x8 a1 = *(const LAS bf16x8*)(kp + 32 * 512 + ((ks * 32) ^ yy));
            S[t][0] = MFMA32(a0, Qf[ks], S[t][0]); S[t][1] = MFMA32(a1, Qf[ks], S[t][1]);
        }
    }
    asm volatile("s_waitcnt lgkmcnt(0)" ::: "memory");
    __builtin_amdgcn_s_barrier();
    asm volatile("" ::: "memory");
#pragma unroll
    for (int t = 0; t < 4; ++t)
#pragma unroll
        for (int i = 0; i < 4; ++i) __builtin_amdgcn_global_load_lds((const unsigned*)(Vb + (size_t)t * 64 * LDK + voff[i]), (LAS unsigned*)(lds + t * TB + (wave * 4 + i) * 1024), 16, 0, 0);
    float mx = fmaxf(S[0][0][0], S[0][1][0]);
#pragma unroll
    for (int t = 0; t < 4; ++t)
#pragma unroll
        for (int r = 0; r < 16; ++r) mx = fmaxf(mx, fmaxf(S[t][0][r], S[t][1][r]));
    mx = fmaxf(mx, __shfl_xor(mx, 32));
    const float nm = -mx * csc;
    float lsum = 0.f;
    bf16x8 pb[4][4];
#pragma unroll
    for (int t = 0; t < 4; ++t) {
#pragma unroll
        for (int r = 0; r < 16; ++r) { S[t][0][r] = fexp2(__builtin_fmaf(S[t][0][r], csc, nm)); S[t][1][r] = fexp2(__builtin_fmaf(S[t][1][r], csc, nm)); lsum += S[t][0][r] + S[t][1][r]; }
#pragma unroll
        for (int sp = 0; sp < 2; ++sp) {
            u32x4 w0, w1;
            w0.x = pk2(S[t][0][8 * sp + 0], S[t][0][8 * sp + 1]); w0.y = pk2(S[t][0][8 * sp + 2], S[t][0][8 * sp + 3]); w0.z = pk2(S[t][0][8 * sp + 4], S[t][0][8 * sp + 5]); w0.w = pk2(S[t][0][8 * sp + 6], S[t][0][8 * sp + 7]);
            w1.x = pk2(S[t][1][8 * sp + 0], S[t][1][8 * sp + 1]); w1.y = pk2(S[t][1][8 * sp + 2], S[t][1][8 * sp + 3]); w1.z = pk2(S[t][1][8 * sp + 4], S[t][1][8 * sp + 5]); w1.w = pk2(S[t][1][8 * sp + 6], S[t][1][8 * sp + 7]);
            pb[t][sp] = __builtin_bit_cast(bf16x8, w0); pb[t][2 + sp] = __builtin_bit_cast(bf16x8, w1);
        }
    }
    lsum += __shfl_xor(lsum, 32);
    const float inv = 1.f / lsum;
    asm volatile("s_waitcnt vmcnt(0)" ::: "memory");
    __builtin_amdgcn_s_barrier();
    asm volatile("" ::: "memory");
    const int q4 = (lane & 15) >> 2, p4 = lane & 3, g16 = (lane >> 4) & 1, q64 = q4 * 64;
    const int vp_off = (4 * h + q4) * 512 + g16 * 32 + p4 * 8;
#pragma unroll 1
    for (int half = 0; half < 2; ++half) {
        f32x16 O[4];
#pragma unroll
        for (int d = 0; d < 4; ++d)
#pragma unroll
            for (int r = 0; r < 16; ++r) O[d][r] = 0.f;
#pragma unroll
        for (int t = 0; t < 4; ++t) {
            const LAS unsigned char* vp = lds + t * TB + vp_off + half * 256;
#pragma unroll
            for (int ks = 0; ks < 4; ++ks) {
#pragma unroll
                for (int d = 0; d < 4; ++d) {
                    const s16x4 r0 = vtr(vp + (16 * ks) * 512 + ((d * 64) ^ q64));
                    const s16x4 r1 = vtr(vp + (16 * ks + 8) * 512 + ((d * 64) ^ q64));
                    const bf16x8 vf = __builtin_shufflevector(r0, r1, 0, 1, 2, 3, 4, 5, 6, 7);
                    O[d] = MFMA32(vf, pb[t][ks], O[d]);
                }
            }
        }
#pragma unroll
        for (int d = 0; d < 4; ++d)
#pragma unroll
            for (int j = 0; j < 4; ++j) { u32x2 w; w.x = pk2(O[d][4 * j] * inv, O[d][4 * j + 1] * inv); w.y = pk2(O[d][4 * j + 2] * inv, O[d][4 * j + 3] * inv);
                *(u32x2*)(orow + half * 128 + 32 * d + 8 * j + 4 * h) = w; }
    }
}

template <int NB> __device__ __forceinline__ void store_ot(const f32x16 (&O)[NB], bf16_t* orow  , int h) {
#pragma unroll
    for (int d = 0; d < NB; ++d)
#pragma unroll
        for (int j = 0; j < 4; ++j) { u32x2 w; w.x = pk2(O[d][4 * j], O[d][4 * j + 1]); w.y = pk2(O[d][4 * j + 2], O[d][4 * j + 3]);
            *(u32x2*)(orow + 32 * d + 8 * j + 4 * h) = w; }
}
}


#define XB_TMO      128
#define XB_XCNT(j)  (256  + 64 * (j))
#define XB_XSUB(j)  (1280 + 64 * (j))
#define XB_XGEN(j)  (2304 + 64 * (j))
#define XB_TOP      3328
#define XB_TOPGEN   3392
#define XCD_BAR_WORDS 3456
#define XB_SPIN_CAP (1u << 22)
__device__ __forceinline__ unsigned xb_ld(unsigned* p)              { return __hip_atomic_load(p, __ATOMIC_RELAXED, __HIP_MEMORY_SCOPE_AGENT); }
__device__ __forceinline__ unsigned xb_add(unsigned* p, unsigned v) { return __hip_atomic_fetch_add(p, v, __ATOMIC_RELAXED, __HIP_MEMORY_SCOPE_AGENT); }
__device__ __forceinline__ unsigned xb_xcc_id() { return (unsigned)__builtin_amdgcn_s_getreg((3 << 11) | 20) & 0xFu; }
#define XB_SPIN(cond, bar) do { unsigned _sp = 0; while (cond) { __builtin_amdgcn_s_sleep(1); \
    if ((++_sp & 255u) == 0u) { if (xb_ld(&(bar)[XB_TMO])) break; if (_sp > XB_SPIN_CAP) { atomicAdd(&(bar)[XB_TMO], 1u); break; } } } } while (0)
struct XcdBarrier { unsigned* bar; unsigned x; volatile LAS unsigned* st; };
__device__ __forceinline__ XcdBarrier xcd_barrier_post(unsigned* bar, volatile LAS unsigned* st) {
    XcdBarrier b; b.bar = bar; b.x = xb_xcc_id(); b.st = st;
    if (threadIdx.x == 0) (void)xb_add(&bar[XB_XCNT(b.x)], 1u);
    return b;
}
__device__ __forceinline__ void xcd_barrier_complete(unsigned* bar, unsigned x, unsigned& nloc, unsigned& nx) {
    const unsigned G = gridDim.x * gridDim.y * gridDim.z;
    unsigned sum, cnt, mine, sp = 0u;
    for (;;) {
        sum = 0u; cnt = 0u; mine = 0u;
#pragma unroll
        for (unsigned j = 0; j < 16; ++j) { const unsigned c = xb_ld(&bar[XB_XCNT(j)]); sum += c; cnt += (c > 0u) ? 1u : 0u; mine = (j == x) ? c : mine; }
        if (sum == G) break;
        __builtin_amdgcn_s_sleep(1);
        if ((++sp & 255u) == 0u) { if (xb_ld(&bar[XB_TMO])) break; if (sp > XB_SPIN_CAP) { atomicAdd(&bar[XB_TMO], 1u); break; } }
    }
    nloc = mine > 0u ? mine : 1u; nx = cnt > 0u ? cnt : 1u;
}
__device__ __forceinline__ void xcd_barrier(const XcdBarrier& b) {
    asm volatile("s_waitcnt vmcnt(0)" ::: "memory");
    __syncthreads();
    if (threadIdx.x == 0) {
        unsigned* bar = b.bar;
        __builtin_amdgcn_s_waitcnt(0);
        unsigned nloc = b.st[0], nx = b.st[1];
        if (nloc == 0u) { xcd_barrier_complete(bar, b.x, nloc, nx); b.st[0] = nloc; b.st[1] = nx; }
        const unsigned old = xb_add(&bar[XB_XSUB(b.x)], 1u);
        const unsigned gen = old / nloc;
        if (old + 1u == (gen + 1u) * nloc) {
            __builtin_amdgcn_fence(__ATOMIC_RELEASE, "agent");
            asm volatile("s_waitcnt vmcnt(0)" ::: "memory");
            const unsigned og = xb_add(&bar[XB_TOP], 1u);
            const unsigned tg = og / nx;
            if (og + 1u == (tg + 1u) * nx) xb_add(&bar[XB_TOPGEN], 1u);
            else XB_SPIN(xb_ld(&bar[XB_TOPGEN]) == tg, bar);
            __builtin_amdgcn_fence(__ATOMIC_ACQUIRE, "agent");
            xb_add(&bar[XB_XGEN(b.x)], 1u);
            asm volatile("s_waitcnt vmcnt(0)" ::: "memory");
        } else {
            XB_SPIN(xb_ld(&bar[XB_XGEN(b.x)]) == gen, bar);
            __builtin_amdgcn_fence(__ATOMIC_ACQUIRE, "agent");
            asm volatile("s_waitcnt vmcnt(0)" ::: "memory");
        }
    }
    __syncthreads();
}

struct Args { const float* in[22]; float* out; unsigned char* ws; int ph_lo, ph_hi; };
constexpr int NWAVES = 8, LDS_BYTES = 147456, NPHASE = 11;

__device__ __forceinline__ void transpose_item(const float* W, int N, bf16_t* WT, int ldt, int k_off, LAS float* scr, int kb, int nb, int lane, const float* gain, int mapmode) {
    const int k0 = 64 * kb, n0 = 32 * nb;
    const int nn = n0 + (lane & 31);
    int src = nn;
    if (mapmode == 1) { if (nn < 1024) src = (nn & ~63) + ((nn & 63) >> 1) + 32 * (nn & 1); }
    else if (mapmode == 2) { src = (nn & 1) ? (DFF + (nn >> 1)) : (nn >> 1); }
    float wv[32];
#pragma unroll
    for (int i = 0; i < 32; ++i) { const int kk = 2 * i + (lane >> 5); wv[i] = __builtin_nontemporal_load(W + (size_t)(k0 + kk) * N + src); }
    if (gain) {
#pragma unroll
        for (int i = 0; i < 32; ++i) wv[i] *= gain[k0 + 2 * i + (lane >> 5)];
    }
#pragma unroll
    for (int i = 0; i < 32; ++i) { const int kk = 2 * i + (lane >> 5); scr[kk * 33 + (lane & 31)] = wv[i]; }
    asm volatile("s_waitcnt lgkmcnt(0)" ::: "memory");
    const int c = lane & 7;
#pragma unroll
    for (int j = 0; j < 4; ++j) { const int n = (lane >> 3) + 8 * j; const LAS float* s = scr + (8 * c) * 33 + n;
        u32x4 o; o.x = pk2(s[0 * 33], s[1 * 33]); o.y = pk2(s[2 * 33], s[3 * 33]); o.z = pk2(s[4 * 33], s[5 * 33]); o.w = pk2(s[6 * 33], s[7 * 33]);
        *(u32x4*)(WT + (size_t)(n0 + n) * ldt + k_off + k0 + 8 * c) = o; }
    asm volatile("s_waitcnt lgkmcnt(0)" ::: "memory");
}

__device__ __forceinline__ void row_to_bf16(const float* xrow, bf16_t* orow, float* rstd_out, int lane) {
    const f32x4* xr = (const f32x4*)xrow + lane;
    f32x4 v[4]; float s = 0.f;
#pragma unroll
    for (int j = 0; j < 4; ++j) { v[j] = xr[64 * j]; s += (v[j].x * v[j].x + v[j].y * v[j].y) + (v[j].z * v[j].z + v[j].w * v[j].w); }
    s = wave_sum(s);
    if (lane == 0) *rstd_out = 1.f / sqrtf(s * (1.f / DM) + EPS);
    u32x2* o8 = (u32x2*)orow + lane;
#pragma unroll
    for (int j = 0; j < 4; ++j) { u32x2 w; w.x = pk2(v[j].x, v[j].y); w.y = pk2(v[j].z, v[j].w); o8[64 * j] = w; }
}

__device__ __forceinline__ void row2_to_bf16(const float* xrow, bf16_t* orow, float* rstd_out, int lane, size_t rstride, int sstride, bool two) {
    const f32x4* xr = (const f32x4*)xrow + lane; const f32x4* xr2 = (const f32x4*)(xrow + (two ? rstride : 0)) + lane;
    f32x4 v[4], w[4]; float s = 0.f, s2 = 0.f;
#pragma unroll
    for (int j = 0; j < 4; ++j) { v[j] = xr[64 * j]; w[j] = xr2[64 * j]; }
#pragma unroll
    for (int j = 0; j < 4; ++j) { s += (v[j].x * v[j].x + v[j].y * v[j].y) + (v[j].z * v[j].z + v[j].w * v[j].w); s2 += (w[j].x * w[j].x + w[j].y * w[j].y) + (w[j].z * w[j].z + w[j].w * w[j].w); }
    s = wave_sum(s); s2 = wave_sum(s2);
    if (lane == 0) { rstd_out[0] = 1.f / sqrtf(s * (1.f / DM) + EPS); if (two) rstd_out[sstride] = 1.f / sqrtf(s2 * (1.f / DM) + EPS); }
    u32x2* o8 = (u32x2*)orow + lane;
#pragma unroll
    for (int j = 0; j < 4; ++j) { u32x2 p; p.x = pk2(v[j].x, v[j].y); p.y = pk2(v[j].z, v[j].w); o8[64 * j] = p; }
    if (two) { u32x2* o9 = (u32x2*)(orow + rstride) + lane;
#pragma unroll
        for (int j = 0; j < 4; ++j) { u32x2 p; p.x = pk2(w[j].x, w[j].y); p.y = pk2(w[j].z, w[j].w); o9[64 * j] = p; } }
}

__device__ __forceinline__ void row4_to_bf16(const float* xrow, bf16_t* orow, float* rstd_out, int lane, size_t rstride, int sstride) {
    f32x4 v[4][4]; float s[4];
#pragma unroll
    for (int q = 0; q < 4; ++q)
#pragma unroll
        for (int j = 0; j < 4; ++j) v[q][j] = __builtin_nontemporal_load((const f32x4*)(xrow + q * rstride) + lane + 64 * j);
#pragma unroll
    for (int q = 0; q < 4; ++q) { s[q] = 0.f;
#pragma unroll
        for (int j = 0; j < 4; ++j) s[q] += (v[q][j].x * v[q][j].x + v[q][j].y * v[q][j].y) + (v[q][j].z * v[q][j].z + v[q][j].w * v[q][j].w); }
#pragma unroll
    for (int o = 1; o < 64; o <<= 1) {
#pragma unroll
        for (int q = 0; q < 4; ++q) s[q] += __shfl_xor(s[q], o); }
    if (lane == 0) {
#pragma unroll
        for (int q = 0; q < 4; ++q) rstd_out[q * sstride] = 1.f / sqrtf(s[q] * (1.f / DM) + EPS); }
#pragma unroll
    for (int q = 0; q < 4; ++q) { u32x2* o8 = (u32x2*)(orow + q * rstride) + lane;
#pragma unroll
        for (int j = 0; j < 4; ++j) { u32x2 p; p.x = pk2(v[q][j].x, v[q][j].y); p.y = pk2(v[q][j].z, v[q][j].w); o8[64 * j] = p; } }
}

__device__ __forceinline__ double sin_poly(double r) {
    const double r2 = r * r; double t = 1.0, s = 1.0;
#pragma unroll
    for (int k = 1; k <= 14; ++k) { t *= -r2 / (double)((2 * k) * (2 * k + 1)); s += t; }
    return r * s;
}
__device__ __forceinline__ double cos_poly(double r) {
    const double r2 = r * r; double t = 1.0, s = 1.0;
#pragma unroll
    for (int k = 1; k <= 15; ++k) { t *= -r2 / (double)((2 * k - 1) * (2 * k)); s += t; }
    return s;
}

__global__ void __launch_bounds__(NWAVES * 64, 2) mk_fwd(Args args) {
    extern __shared__ __attribute__((aligned(16))) unsigned char lds_raw[];
    LAS unsigned char* lds = (LAS unsigned char*)lds_raw;
    const int tid = threadIdx.x, lane = tid & 63, wave = __builtin_amdgcn_readfirstlane(tid >> 6);
    const int G = gridDim.x, bx = blockIdx.x;
    unsigned char* ws = args.ws;
    float* stats = (float*)(ws + WS_STATS);
    const float* x = args.in[0]; const float* mem = args.in[1];
    bf16_t* WinT = (bf16_t*)(ws + WS_WIN); bf16_t* WupT = (bf16_t*)(ws + WS_WUP); bf16_t* WoutT = (bf16_t*)(ws + WS_WOUT); bf16_t* WcqT = (bf16_t*)(ws + WS_WCQ);
    bf16_t* WckvT = (bf16_t*)(ws + WS_WCKV); bf16_t* WcoT = (bf16_t*)(ws + WS_WCO); bf16_t* WguT = (bf16_t*)(ws + WS_WGU); bf16_t* WdT = (bf16_t*)(ws + WS_WD);
    bf16_t* KVX = (bf16_t*)(ws + WS_KVX); bf16_t* MEMB = (bf16_t*)(ws + WS_MEMB); bf16_t* XB = (bf16_t*)(ws + WS_XB); bf16_t* Y = XB;
    bf16_t* QKV = (bf16_t*)(ws + WS_QKV); bf16_t* T = (bf16_t*)(ws + WS_T); bf16_t* QX = (bf16_t*)(ws + WS_QX); bf16_t* OX = (bf16_t*)(ws + WS_OX);
    bf16_t* ACT = (bf16_t*)(ws + WS_ACT); bf16_t* GB = (bf16_t*)(ws + WS_G); bf16_t* X1B = (bf16_t*)(ws + WS_X1B); bf16_t* X2B = (bf16_t*)(ws + WS_X2B);
    float* out = args.out;
    const int lo = args.ph_lo, hi = args.ph_hi;
#ifndef PH_MASK
#define PH_MASK 0x7ff
#endif
#define IN(k) (((PH_MASK >> (k)) & 1) && lo <= (k) && (k) < hi)
#if ONE_LAUNCH
    volatile LAS unsigned* bst = (volatile LAS unsigned*)(lds + LDS_BYTES - 64);
    if (tid < 2) bst[tid] = 0u;
    __syncthreads();
    const XcdBarrier xbar = xcd_barrier_post((unsigned*)(ws + WS_CTL), bst);
#define SEAM(k) do { if (IN(k) && IN((k) + 1)) xcd_barrier(xbar); } while (0)
    if (args.ph_lo < 0) cg::this_grid().sync();
#else
#define SEAM(k) do { } while (0)
#endif

    if (IN(0)) for (int prb = 0; prb < REP_P0; ++prb) {
        LAS float* scr = (LAS float*)(lds + wave * 16384);
        const int gw = bx * NWAVES + wave, NGW = G * NWAVES;
        constexpr int I_IN = 16 * 160, I_UP = 8 * 32, I_SQ = 16 * 32, I_CKV = 16 * 64, I_GU = 16 * 176, I_D = 44 * 32;
        constexpr int NITEMS = I_IN + 2 * I_UP + 3 * I_SQ + I_CKV + I_GU + I_D;
        for (int it = gw; it < NITEMS; it += NGW) {
            int r = it;
            if (r < I_IN) { transpose_item(args.in[3], INC, WinT, DM, 0, scr, r / 160, r % 160, lane, args.in[2], 1); continue; } r -= I_IN;
            if (r < I_UP) { transpose_item(args.in[10], DM, WupT, DM, 0, scr, r / 32, r % 32, lane, nullptr, 0); continue; } r -= I_UP;
            if (r < I_UP) { transpose_item(args.in[11], DM, WupT, DM, 512, scr, r / 32, r % 32, lane, nullptr, 0); continue; } r -= I_UP;
            if (r < I_SQ) { transpose_item(args.in[12], DM, WoutT, DM, 0, scr, r / 32, r % 32, lane, nullptr, 0); continue; } r -= I_SQ;
            if (r < I_SQ) {
#pragma unroll
                for (int q = 0; q < 2; ++q) { const int k = 2 * r + q; const float gk = args.in[13][k]; const f32x4* wr_ = (const f32x4*)(args.in[15] + (size_t)k * DM) + lane; u32x2* o8 = (u32x2*)(WcqT + (size_t)k * DM) + lane;
#pragma unroll
                    for (int j = 0; j < 4; ++j) { const f32x4 v = wr_[64 * j] * gk; u32x2 w; w.x = pk2(v.x, v.y); w.y = pk2(v.z, v.w); o8[64 * j] = w; } }
                continue; } r -= I_SQ;
            if (r < I_SQ) { transpose_item(args.in[17], DM, WcoT, DM, 0, scr, r / 32, r % 32, lane, nullptr, 0); continue; } r -= I_SQ;
            if (r < I_CKV) { transpose_item(args.in[16], 2 * DM, WckvT, DM, 0, scr, r / 64, r % 64, lane, args.in[14], 0); continue; } r -= I_CKV;
            if (r < I_GU) { transpose_item(args.in[19], 2 * DFF, WguT, DM, 0, scr, r / 176, r % 176, lane, args.in[18], 2); continue; } r -= I_GU;
            transpose_item(args.in[20], DM, WdT, DFF, 0, scr, r / 32, r % 32, lane, nullptr, 0);
        }
        for (int m = gw; m < MROWS; m += 4 * NGW) {
            if (m + 3 * NGW < MROWS) row4_to_bf16(x + (size_t)m * DM, XB + (size_t)m * DM, stats + ST_RSTD1 + m, lane, (size_t)NGW * DM, NGW);
            else for (int mm = m; mm < MROWS; mm += NGW) row_to_bf16(x + (size_t)mm * DM, XB + (size_t)mm * DM, stats + ST_RSTD1 + mm, lane);
        }
        for (int m = gw; m < MEMROWS; m += NGW) row_to_bf16(mem + (size_t)m * DM, MEMB + (size_t)m * DM, stats + ST_RSTDM + m, lane);
        const int gt = bx * (NWAVES * 64) + tid, NGT = G * NWAVES * 64;
        for (int i = gt; i < 3 * MROWS; i += NGT) stats[ST_SSQ2 + i] = 0.f;
        for (int i = gt; i < SEQ * 32; i += NGT) {
            const int pos = i >> 5, fi = i & 31;
            const float inv = (float)exp2(-(double)fi * (13.287712379549449 / 32.0));
            const float ang = (float)pos * inv;
            const double a = (double)ang; const double k = rint(a * 0.15915494309189535); const double rr = fma(-k, 6.283185307179586, a) - k * 2.4492935982947064e-16;
            stats[ST_COS + i] = (float)cos_poly(rr); stats[ST_SIN + i] = (float)sin_poly(rr);
        }
        if (gt < 64) {
            const float a = wave_sum(args.in[4][lane] * args.in[5][lane]), b = wave_sum(args.in[6][lane] * args.in[7][lane]);
            if (gt == 0) stats[ST_LAM] = expf(a) - expf(b) + 0.2f;
        }
    }
    SEAM(0);

    if (IN(1)) for (int prb = 0; prb < REP_P1; ++prb) {
        { pg8::Gemm g{XB, WinT, DM, DM, DM}; pg8::StaticOrder S; S.init(MROWS, INC, G, bx, 10);
          pg8::EpiZ E{QKV, GB, stats + ST_RSTD1, stats + ST_COS, stats + ST_SIN};
          pg8::gemm_phase(lds, g, S, E); }
        { pg8::Gemm g{MEMB, WckvT, DM, DM, DM}; pg8::StaticOrder S; S.init(2 * MEMROWS, 2 * DM, G, bx);
          pg8::EpiScaleHalf E{KVX, 2 * DM, stats + ST_RSTDM};
          pg8::gemm_phase<pg8::EpiScaleHalf, false, true, pg8::StaticOrder, true>(lds, g, S, E); }
    }
    SEAM(1);

#ifndef REP_P2
#define REP_P2 1
#endif
#ifndef REP_P6
#define REP_P6 1
#endif
    if (IN(2)) for (int prb = 0; prb < REP_P2; ++prb) {
        const float lam = stats[ST_LAM];
        const float* subln = args.in[8]; const float* relb = args.in[9];
        const int l31 = lane & 31, h = lane >> 5;
#ifndef NO_A
        for (int i0 = bx; i0 < 256; i0 += G) {
#pragma unroll 1
            for (int rep = 0; rep < 2; ++rep) {
                const int i = rep ? 511 - i0 : i0;
                const int qb = 7 - (i >> 6), bh = i & 63, b = bh >> 2, hd = bh & 3;
                const int q0 = qb * 256 + wave * 32, cw = 4 * qb + (wave >> 1);
                const size_t rowb = (size_t)b * SEQ;
                f32x16 O1[4], O2[4];
                bf16_t* yrow = Y + (rowb + q0 + l31) * DM + hd * 128;
                fa::flash_pass_dma<128, 0>(lds, QKV + (rowb + q0) * QKVW + hd * 128, QKVW, QKV + rowb * QKVW + 512 + hd * 128, QKVW, QKV + rowb * QKVW + 1024 + hd * 128, QKVW,
                                           0, 4 * qb + 4, 0, cw + 1, 0.125f * LOG2E, 0, O1);
                fa::store_ot<4>(O1, yrow, h);
                fa::flash_pass_dma<128, 0>(lds, QKV + (rowb + q0) * QKVW + hd * 128 + 64, QKVW, QKV + rowb * QKVW + 512 + hd * 128 + 64, QKVW, QKV + rowb * QKVW + 1024 + hd * 128, QKVW,
                                           0, 4 * qb + 4, 0, cw + 1, 0.125f * LOG2E, 0, O2);
                float ss = 0.f;
#pragma unroll
                for (int d = 0; d < 4; ++d)
#pragma unroll
                    for (int j = 0; j < 4; ++j) { const u32x2 w = *(const u32x2*)(yrow + 32 * d + 8 * j + 4 * h);
                        O1[d][4 * j] = bflo(w.x) - lam * O2[d][4 * j]; O1[d][4 * j + 1] = bfhi(w.x) - lam * O2[d][4 * j + 1];
                        O1[d][4 * j + 2] = bflo(w.y) - lam * O2[d][4 * j + 2]; O1[d][4 * j + 3] = bfhi(w.y) - lam * O2[d][4 * j + 3];
#pragma unroll
                        for (int e = 0; e < 4; ++e) ss += O1[d][4 * j + e] * O1[d][4 * j + e]; }
                ss += __shfl_xor(ss, 32);
                const float rn = __builtin_amdgcn_rsqf(ss * (1.f / 128.f) + EPS) * 0.8f;
#pragma unroll
                for (int d = 0; d < 4; ++d)
#pragma unroll
                    for (int j = 0; j < 4; ++j) { const f32x4 gsub = *(const f32x4*)(subln + 32 * d + 8 * j + 4 * h);
#pragma unroll
                        for (int e = 0; e < 4; ++e) O1[d][4 * j + e] *= rn * gsub[e]; }
                fa::store_ot<4>(O1, yrow, h);
            }
        }
#endif
#ifndef NO_B
        for (int j = bx; j < 1024; j += G) {
            const int qb = j >> 7, bh = j & 127, b = bh >> 3, hd = bh & 7;
            const int c0 = 4 * qb, cw = c0 + (wave >> 1), q0 = qb * 256 + wave * 32;
            const size_t rowb = (size_t)b * SEQ;
            __syncthreads();
            { LAS float* bl = (LAS float*)(lds + fa::BIAS_OFF);
              for (int i = tid; i < 4 * fa::BIAS_COPY_N; i += NWAVES * 64) { const int k = i / fa::BIAS_COPY_N, jj = i - k * fa::BIAS_COPY_N; const int v = jj + k;
                  bl[i] = relb[hd * 513 + min(max(575 - v, -256), 256) + 256] * LOG2E; } }
            f32x16 O[2];
            fa::flash_pass_dma<64, 1>(lds, QKV + (rowb + q0) * QKVW + 1536 + hd * 64, QKVW, QKV + rowb * QKVW + 2048 + hd * 64, QKVW, QKV + rowb * QKVW + 2560 + hd * 64, QKVW,
                                      max(0, c0 - 8), c0 + 4, max(0, cw - 8), cw + 1, 0.125f * LOG2E, q0, O);
            fa::store_ot<2>(O, Y + (rowb + q0 + l31) * DM + 512 + hd * 64, h);
        }
#endif
    }
    SEAM(2);

    if (IN(3)) {
        pg8::Gemm g{Y, WupT, DM, DM, 512}; pg8::StaticOrder S; S.init(MROWS, DM, G, bx); pg8::EpiGateMerged E{T, GB};
        pg8::gemm_phase<pg8::EpiGateMerged, true>(lds, g, S, E);
    }
#ifndef NO_PRE
    if (IN(3)) {
        bf16_t* WKt = (bf16_t*)(ws + WS_OX); bf16_t* VWt = WKt + (size_t)16 * 1024 * 1024;
        int kpre = 256; asm volatile("" : "+s"(kpre));
        { pg8::Gemm g{KVX, WcqT, 2 * DM, DM, kpre}; pg8::PreOrder<0> S{G, bx, KVX, WcqT};
          pg8::EpiScale<false> E{WKt, DM, nullptr, 0.0625f * LOG2E}; pg8::gemm_phase<pg8::EpiScale<false>, false, true, pg8::PreOrder<0>>(lds, g, S, E); }
        { pg8::Gemm g{WcoT, KVX, DM, 2 * DM, kpre}; pg8::PreOrder<1> S{G, bx, KVX, WcoT};
          pg8::EpiScale<false> E{VWt, DM, nullptr, 1.f}; pg8::gemm_phase<pg8::EpiScale<false>, false, true, pg8::PreOrder<1>>(lds, g, S, E); }
    }
#endif
    SEAM(3);

    if (IN(4)) {
        pg8::Gemm g{T, WoutT, DM, DM, DM}; pg8::StaticOrder S; S.init(MROWS, DM, G, bx);
        pg8::EpiResid<true> E{x, nullptr, X1B, stats + ST_SSQ2}; pg8::gemm_phase(lds, g, S, E);
    }
    SEAM(4);

    if (IN(5)) {
        const bf16_t* WKt = (const bf16_t*)(ws + WS_OX);
        pg8::Gemm g{X1B, WKt, DM, DM, DM, (size_t)1024 * 1024 * 2}; pg8::StaticOrder S; S.init(MROWS, DM, G, bx);
        pg8::EpiSoftmax E{QX, stats + ST_SSQ2, (LAS float*)(lds + 131072)}; pg8::gemm_phase(lds, g, S, E);
    }
    SEAM(6);

    if (IN(7)) {
        const bf16_t* VWt = (const bf16_t*)(ws + WS_OX) + (size_t)16 * 1024 * 1024;
        pg8::Gemm g{QX, VWt, DM, DM, DM, (size_t)1024 * 1024 * 2}; pg8::StaticOrder S; S.init(MROWS, DM, G, bx);
        pg8::EpiResid<false> E{nullptr, X1B, X2B, stats + ST_SSQ3}; pg8::gemm_phase(lds, g, S, E);
    }
    SEAM(7);

    if (IN(8)) for (int prb = 0; prb < REP_P8; ++prb) {
        pg8::Gemm g{X2B, WguT, DM, DM, DM}; pg8::StaticOrder S; S.init(MROWS, 2 * DFF, G, bx, 9);
        pg8::EpiSwiGLU E{ACT, stats + ST_SSQ3}; pg8::gemm_phase(lds, g, S, E);
    }
    SEAM(8);

    if (IN(9)) {
        pg8::Gemm g{ACT, WdT, DFF, DFF, DFF}; pg8::StaticOrder S; S.init(MROWS, DM, G, bx);
        pg8::EpiResid<false> E{nullptr, X2B, X1B  , stats + ST_SSQ4}; pg8::gemm_phase(lds, g, S, E);
    }
    SEAM(9);

    if (IN(10)) {
        const float* gf = args.in[21];
        const int gw = bx * NWAVES + wave, NGW = G * NWAVES;
        for (int m0 = gw; m0 < MROWS; m0 += 4 * NGW) {
            u32x2 w[4][4]; float rs[4];
#pragma unroll
            for (int q = 0; q < 4; ++q) { const int m = min(m0 + q * NGW, MROWS - 1); rs[q] = stats[ST_SSQ4 + m];
#pragma unroll
                for (int j = 0; j < 4; ++j) w[q][j] = __builtin_nontemporal_load((const u32x2*)(X1B + (size_t)m * DM) + lane + 64 * j); }
#pragma unroll
            for (int q = 0; q < 4; ++q) { const int m = m0 + q * NGW; if (m < MROWS) { const float r = __builtin_amdgcn_rsqf(rs[q] * (1.f / DM) + EPS);
                f32x4* xr = (f32x4*)(out + (size_t)m * DM) + lane;
#pragma unroll
                for (int j = 0; j < 4; ++j) { const f32x4 gg = *((const f32x4*)gf + lane + 64 * j);
                    __builtin_nontemporal_store((f32x4){bflo(w[q][j].x), bfhi(w[q][j].x), bflo(w[q][j].y), bfhi(w[q][j].y)} * r * gg, &xr[64 * j]); } } }
        }
    }
#undef IN
#undef SEAM
}

extern "C" void kernel_launch(void* const* d_in, const int* in_sizes, int n_in, void* d_out, int out_size, void* d_ws, size_t ws_size, hipStream_t stream) {
    static int grid = 0;
    if (grid == 0) {
        if (n_in != 22 || out_size != MROWS * DM || ws_size < WS_END) { fprintf(stderr, "kernel_launch: unexpected shapes (n_in %d out %d ws %zu)\n", n_in, out_size, ws_size); grid = -1; return; }
        int dev = 0, cus = 0, per_cu = 0;
        hipGetDevice(&dev); hipDeviceGetAttribute(&cus, hipDeviceAttributeMultiprocessorCount, dev);
        if (hipFuncSetAttribute((const void*)mk_fwd, hipFuncAttributeMaxDynamicSharedMemorySize, LDS_BYTES) != hipSuccess) { fprintf(stderr, "kernel_launch: hipFuncSetAttribute failed\n"); grid = -1; return; }
        if (hipOccupancyMaxActiveBlocksPerMultiprocessor(&per_cu, (const void*)mk_fwd, NWAVES * 64, LDS_BYTES) != hipSuccess || per_cu < 1) { per_cu = 1; (void)hipGetLastError(); }
        grid = cus * 1;
        fprintf(stderr, "kernel_launch: grid %d (occupancy query %d per CU)\n", grid, per_cu);
    }
    if (grid < 0) return;
#if ONE_LAUNCH
    if (hipMemsetAsync((char*)d_ws + WS_CTL, 0, XCD_BAR_WORDS * 4, stream) != hipSuccess) { fprintf(stderr, "kernel_launch: memset failed\n"); return; }
#endif
    Args a{};
    for (int i = 0; i < 22; ++i) a.in[i] = (const float*)d_in[i];
    a.out = (float*)d_out; a.ws = (unsigned char*)d_ws;
#if ONE_LAUNCH
    a.ph_lo = 0; a.ph_hi = NPHASE;
    void* kargs[] = {&a};
    hipError_t e = hipLaunchCooperativeKernel((const void*)mk_fwd, dim3(grid), dim3(NWAVES * 64), kargs, LDS_BYTES, stream);
    if (e != hipSuccess) fprintf(stderr, "cooperative launch failed: %s (grid %d)\n", hipGetErrorString(e), grid);
#else
#ifndef PROBE_MASK
#define PROBE_MASK 0
#endif
    for (int p = 0; p < NPHASE; ++p) { a.ph_lo = p; a.ph_hi = p + 1; const int nrep = ((PROBE_MASK >> p) & 1) ? 2 : 1;
        for (int r = 0; r < nrep; ++r) hipLaunchKernelGGL(mk_fwd, dim3(grid), dim3(NWAVES * 64), LDS_BYTES, stream, a); }
#endif
}
```
